# Optimizing an MI355X kernel written in HIP

```python
import math
import jax, jax.numpy as jnp
from jax import lax
import numpy as np

D_MODEL = 1024
BATCH = 16
SEQ = 2048
DEPTH = 4

CTX_LEN = 256
GRID_W = 64
MIX = D_MODEL
BRANCH_W = MIX // 4
Q_BLOCK = 128
ROPE_THETA = 10000.0
EPS = 1e-6
DA_HEADS = 4
DA_QK = BRANCH_W // (2 * DA_HEADS)
DA_V = BRANCH_W // DA_HEADS
GQ_HEADS = 4
GQ_KV_HEADS = 2
GQ_HD = BRANCH_W // GQ_HEADS
SG_GROUPS = 4
SG_CHUNK = 128
GLA_HEADS = 4
GLA_DV = BRANCH_W // GLA_HEADS
GLA_DK = GLA_DV // 2
GLA_RANK = 16
GLA_NORMALIZER = 16.0
GLA_CHUNK = 32

IN_SIZES = (
    DA_HEADS * 2 * DA_QK, DA_HEADS * 2 * DA_QK, DA_HEADS * DA_V, BRANCH_W,
    GQ_HEADS * GQ_HD, GQ_KV_HEADS * GQ_HD, GQ_KV_HEADS * GQ_HD, BRANCH_W,
    BRANCH_W, BRANCH_W, BRANCH_W,
    GLA_HEADS * GLA_DK, GLA_HEADS * GLA_DK, GLA_HEADS * GLA_DV, BRANCH_W,
    GLA_RANK, GLA_RANK,
)
P_IN = sum(IN_SIZES)

kernel_name = "hybrid_parallel_heads_flow_backbone"


def rms_norm(x, g):
    xf = x.astype(jnp.float32)
    y = xf * lax.rsqrt(jnp.mean(xf * xf, axis=-1, keepdims=True) + EPS)
    return (y * g.astype(jnp.float32)).astype(x.dtype)


def layer_norm(x, g, b):
    xf = x.astype(jnp.float32)
    mu = jnp.mean(xf, axis=-1, keepdims=True)
    var = jnp.mean(jnp.square(xf - mu), axis=-1, keepdims=True)
    y = (xf - mu) * lax.rsqrt(var + EPS)
    return (y * g.astype(jnp.float32) + b.astype(jnp.float32)).astype(x.dtype)


def split_cols(p):
    out = []
    off = 0
    for n in IN_SIZES:
        out.append(p[..., off:off + n])
        off += n
    return out


def rope_angles(pos, dim):
    inv = ROPE_THETA ** (-jnp.arange(0, dim, 2, dtype=jnp.float32) / dim)
    return pos.astype(jnp.float32)[:, None] * inv[None, :]


def rope_1d(x, ang):
    half = x.shape[-1] // 2
    shape = (ang.shape[0],) + (1,) * (x.ndim - 3) + (half,)
    cos = jnp.cos(ang).reshape(shape)
    sin = jnp.sin(ang).reshape(shape)
    xf = x.astype(jnp.float32)
    x1, x2 = xf[..., :half], xf[..., half:]
    return jnp.concatenate([x1 * cos - x2 * sin, x1 * sin + x2 * cos], axis=-1).astype(x.dtype)


def rope_2d(x, rows, cols):
    h = x.shape[-1] // 2
    return jnp.concatenate([rope_1d(x[..., :h], rope_angles(rows, h)),
                            rope_1d(x[..., h:], rope_angles(cols, h))], axis=-1)


def sweep_query_blocks(fn, q):
    b, t = q.shape[:2]
    nb = t // Q_BLOCK
    qb = jnp.moveaxis(q.reshape((b, nb, Q_BLOCK) + q.shape[2:]), 1, 0)
    ob = lax.map(fn, qb)
    return jnp.moveaxis(ob, 0, 1).reshape((b, t) + ob.shape[3:])


def diff_attn_core(q, k, v, lam, lam_init, subln_g):
    s = jnp.einsum('bqhmd,bkhmd->bhmqk', q, k).astype(jnp.float32) * (DA_QK ** -0.5)
    p = jax.nn.softmax(s, axis=-1)
    w = p[:, :, 0] - lam * p[:, :, 1]
    o = jnp.einsum('bhqk,bkhd->bqhd', w.astype(v.dtype), v)
    return rms_norm(o, subln_g) * (1.0 - lam_init)


def diff_attention_branch(q_l, k_l, v_l, q_c, k_c, v_c, lq1, lk1, lq2, lk2, subln_g,
                          lam_init, rows, cols, with_ctx):
    b, t = q_l.shape[:2]
    tc = q_c.shape[1]
    q_l = rope_2d(q_l.reshape(b, t, DA_HEADS, 2, DA_QK), rows, cols)
    k_l = rope_2d(k_l.reshape(b, t, DA_HEADS, 2, DA_QK), rows, cols)
    k_c = k_c.reshape(b, tc, DA_HEADS, 2, DA_QK)
    v_l = v_l.reshape(b, t, DA_HEADS, DA_V)
    v_c = v_c.reshape(b, tc, DA_HEADS, DA_V)
    lam = (jnp.exp(jnp.sum((lq1 * lk1).astype(jnp.float32)))
           - jnp.exp(jnp.sum((lq2 * lk2).astype(jnp.float32))) + lam_init)
    k_all = jnp.concatenate([k_c, k_l], axis=1)
    v_all = jnp.concatenate([v_c, v_l], axis=1)
    y_l = sweep_query_blocks(lambda qb: diff_attn_core(qb, k_all, v_all, lam, lam_init, subln_g), q_l)
    y_l = y_l.reshape(b, t, DA_HEADS * DA_V)
    y_c = None
    if with_ctx:
        q_c = q_c.reshape(b, tc, DA_HEADS, 2, DA_QK)
        y_c = diff_attn_core(q_c, k_c, v_c, lam, lam_init, subln_g).reshape(b, tc, DA_HEADS * DA_V)
    return y_l, y_c


def gqa_core(q, k, v):
    s = jnp.einsum('bqhgd,bkhd->bhgqk', q, k).astype(jnp.float32) * (GQ_HD ** -0.5)
    p = jax.nn.softmax(s, axis=-1)
    return jnp.einsum('bhgqk,bkhd->bqhgd', p.astype(v.dtype), v)


def gqa_branch(q_l, k_l, v_l, q_c, k_c, v_c, qn_g, kn_g, rows, cols, with_ctx):
    b, t = q_l.shape[:2]
    tc = q_c.shape[1]
    grp = GQ_HEADS // GQ_KV_HEADS
    q_l = rope_2d(rms_norm(q_l.reshape(b, t, GQ_HEADS, GQ_HD), qn_g), rows, cols)
    k_l = rope_2d(rms_norm(k_l.reshape(b, t, GQ_KV_HEADS, GQ_HD), kn_g), rows, cols)
    k_c = rms_norm(k_c.reshape(b, tc, GQ_KV_HEADS, GQ_HD), kn_g)
    v_l = v_l.reshape(b, t, GQ_KV_HEADS, GQ_HD)
    v_c = v_c.reshape(b, tc, GQ_KV_HEADS, GQ_HD)
    k_all = jnp.concatenate([k_c, k_l], axis=1)
    v_all = jnp.concatenate([v_c, v_l], axis=1)
    q_l = q_l.reshape(b, t, GQ_KV_HEADS, grp, GQ_HD)
    y_l = sweep_query_blocks(lambda qb: gqa_core(qb, k_all, v_all), q_l).reshape(b, t, GQ_HEADS * GQ_HD)
    y_c = None
    if with_ctx:
        q_c = rms_norm(q_c.reshape(b, tc, GQ_HEADS, GQ_HD), qn_g).reshape(b, tc, GQ_KV_HEADS, grp, GQ_HD)
        y_c = gqa_core(q_c, k_c, v_c).reshape(b, tc, GQ_HEADS * GQ_HD)
    return y_l, y_c


def chunk_sgu(u, v, ln_g, ln_b, w_s, b_s):
    b, t, w = u.shape
    n = t // SG_CHUNK
    vn = layer_norm(v, ln_g, ln_b).reshape(b, n, SG_CHUNK, SG_GROUPS, w // SG_GROUPS)
    mixed = jnp.einsum('gij,bnjgc->bnigc', w_s, vn) + b_s.T[:, :, None]
    return u * mixed.reshape(b, t, w)


def gla_scan(q, k, v, g, s0):
    b, t, h, _ = q.shape
    dv = v.shape[-1]
    nc = t // GLA_CHUNK

    def to_chunks(a):
        return a.astype(jnp.float32).reshape(b, nc, GLA_CHUNK, h, a.shape[-1]).transpose(1, 0, 3, 2, 4)

    mask = jnp.tril(jnp.ones((GLA_CHUNK, GLA_CHUNK), dtype=bool))

    def step(s, inp):
        qc, kc, vc, gc = inp
        cum = jnp.cumsum(gc, axis=2)
        cum_last = cum[:, :, -1:, :]
        qe = qc * jnp.exp(cum)
        a = jnp.einsum('bhid,bhjd->bhij', qe, kc * jnp.exp(-cum))
        a = jnp.where(mask, a, 0.0)
        o = jnp.einsum('bhij,bhjv->bhiv', a, vc) + jnp.einsum('bhid,bhdv->bhiv', qe, s)
        s = (jnp.exp(cum_last[:, :, 0, :])[..., None] * s
             + jnp.einsum('bhjd,bhjv->bhdv', kc * jnp.exp(cum_last - cum), vc))
        return s, o

    s_fin, o = lax.scan(step, s0, (to_chunks(q), to_chunks(k), to_chunks(v), to_chunks(g)))
    o = o.transpose(1, 0, 3, 2, 4).reshape(b, t, h, dv)
    return o.astype(v.dtype), s_fin


def gla_heads(q, k, v, rf, rb, w2_f, b_f, w2_b, b_b):
    b, t = q.shape[:2]
    q = q.reshape(b, t, GLA_HEADS, GLA_DK) * (GLA_DK ** -0.5)
    k = k.reshape(b, t, GLA_HEADS, GLA_DK)
    v = v.reshape(b, t, GLA_HEADS, GLA_DV)
    gf = (jax.nn.log_sigmoid((rf @ w2_f + b_f).astype(jnp.float32)) / GLA_NORMALIZER).reshape(b, t, GLA_HEADS, GLA_DK)
    gb = (jax.nn.log_sigmoid((rb @ w2_b + b_b).astype(jnp.float32)) / GLA_NORMALIZER).reshape(b, t, GLA_HEADS, GLA_DK)
    return q, k, v, gf, gb


def gla_branch(q_l, k_l, v_l, rf_l, rb_l, q_c, k_c, v_c, rf_c, rb_c,
               w2_f, b_f, w2_b, b_b, norm_g, with_ctx):
    ql, kl, vl, gfl, gbl = gla_heads(q_l, k_l, v_l, rf_l, rb_l, w2_f, b_f, w2_b, b_b)
    qc, kc, vc, gfc, gbc = gla_heads(q_c, k_c, v_c, rf_c, rb_c, w2_f, b_f, w2_b, b_b)
    b, t = ql.shape[:2]
    tc = qc.shape[1]
    s0 = jnp.zeros((b, GLA_HEADS, GLA_DK, GLA_DV), jnp.float32)
    flip = lambda a: jnp.flip(a, axis=1)
    oc_f, sc_f = gla_scan(qc, kc, vc, gfc, s0)
    oc_b, sc_b = gla_scan(flip(qc), flip(kc), flip(vc), flip(gbc), s0)
    ol_f, _ = gla_scan(ql, kl, vl, gfl, sc_f)
    ol_b, _ = gla_scan(flip(ql), flip(kl), flip(vl), flip(gbl), sc_b)
    y_l = rms_norm(ol_f + flip(ol_b), norm_g).reshape(b, t, GLA_HEADS * GLA_DV)
    y_c = None
    if with_ctx:
        y_c = rms_norm(oc_f + flip(oc_b), norm_g).reshape(b, tc, GLA_HEADS * GLA_DV)
    return y_l, y_c


def setup_inputs(seed: int = 0) -> dict:
    key = jax.random.key(seed)
    ks = jax.random.split(key, 32)

    def nrm(k, shape, s):
        return jax.random.normal(k, shape, jnp.float32) * s

    L = DEPTH
    return {
        "x": nrm(ks[0], (BATCH, SEQ, D_MODEL), 1.0),
        "c": nrm(ks[1], (BATCH, D_MODEL), 1.0),
        "ctx": nrm(ks[2], (BATCH, CTX_LEN, D_MODEL), 1.0),
        "c_ctx": nrm(ks[3], (D_MODEL,), 1.0),
        "ada_w": nrm(ks[4], (L, D_MODEL, 3 * D_MODEL), 0.5 * D_MODEL ** -0.5),
        "ada_b": nrm(ks[5], (L, 3 * D_MODEL), 0.02),
        "norm_g": 1.0 + nrm(ks[6], (L, D_MODEL), 0.02),
        "w_in": nrm(ks[7], (L, D_MODEL, P_IN), D_MODEL ** -0.5),
        "da_lq1": nrm(ks[8], (L, DA_QK), 0.1),
        "da_lk1": nrm(ks[9], (L, DA_QK), 0.1),
        "da_lq2": nrm(ks[10], (L, DA_QK), 0.1),
        "da_lk2": nrm(ks[11], (L, DA_QK), 0.1),
        "da_subln_g": 1.0 + nrm(ks[12], (L, DA_V), 0.02),
        "gq_qnorm_g": 1.0 + nrm(ks[13], (L, GQ_HD), 0.02),
        "gq_knorm_g": 1.0 + nrm(ks[14], (L, GQ_HD), 0.02),
        "sg_ln_g": 1.0 + nrm(ks[15], (L, BRANCH_W), 0.02),
        "sg_ln_b": nrm(ks[16], (L, BRANCH_W), 0.02),
        "sg_w": nrm(ks[17], (L, SG_GROUPS, SG_CHUNK, SG_CHUNK), SG_CHUNK ** -0.5),
        "sg_b": 1.0 + nrm(ks[18], (L, SG_GROUPS, SG_CHUNK), 0.02),
        "gla_w2_f": nrm(ks[19], (L, GLA_RANK, GLA_HEADS * GLA_DK), GLA_RANK ** -0.5),
        "gla_b_f": nrm(ks[20], (L, GLA_HEADS * GLA_DK), 0.5),
        "gla_w2_b": nrm(ks[21], (L, GLA_RANK, GLA_HEADS * GLA_DK), GLA_RANK ** -0.5),
        "gla_b_b": nrm(ks[22], (L, GLA_HEADS * GLA_DK), 0.5),
        "gla_norm_g": 1.0 + nrm(ks[23], (L, GLA_DV), 0.02),
        "w_out": nrm(ks[24], (L, MIX, D_MODEL), MIX ** -0.5),
        "final_norm_g": 1.0 + nrm(ks[25], (D_MODEL,), 0.02),
    }


def reference(x, c, ctx, c_ctx, ada_w, ada_b, norm_g, w_in, da_lq1, da_lk1, da_lq2, da_lk2,
              da_subln_g, gq_qnorm_g, gq_knorm_g, sg_ln_g, sg_ln_b, sg_w, sg_b,
              gla_w2_f, gla_b_f, gla_w2_b, gla_b_b, gla_norm_g, w_out, final_norm_g):
    n_rows = x.shape[1] // GRID_W
    rows = jnp.repeat(jnp.arange(n_rows, dtype=jnp.int32), GRID_W)
    cols = jnp.tile(jnp.arange(GRID_W, dtype=jnp.int32), n_rows)
    silu_c = jax.nn.silu(c)
    silu_cc = jax.nn.silu(c_ctx)
    xl, xc = x, ctx
    for i in range(DEPTH):
        with_ctx = i < DEPTH - 1
        lam_init = 0.8 - 0.6 * math.exp(-0.3 * i)
        mod_l = silu_c @ ada_w[i] + ada_b[i]
        mod_c = silu_cc @ ada_w[i] + ada_b[i]
        sh_l, sc_l, gt_l = jnp.split(mod_l, 3, axis=-1)
        sh_c, sc_c, gt_c = jnp.split(mod_c, 3, axis=-1)
        hl = rms_norm(xl, norm_g[i]) * (1.0 + sc_l[:, None]) + sh_l[:, None]
        hc = rms_norm(xc, norm_g[i]) * (1.0 + sc_c) + sh_c
        (aq_l, ak_l, av_l, az_l, bq_l, bk_l, bv_l, bz_l, cu_l, cv_l, cz_l,
         dq_l, dk_l, dv_l, dz_l, drf_l, drb_l) = split_cols(hl @ w_in[i])
        (aq_c, ak_c, av_c, az_c, bq_c, bk_c, bv_c, bz_c, cu_c, cv_c, cz_c,
         dq_c, dk_c, dv_c, dz_c, drf_c, drb_c) = split_cols(hc @ w_in[i])

        ya_l, ya_c = diff_attention_branch(aq_l, ak_l, av_l, aq_c, ak_c, av_c,
                                           da_lq1[i], da_lk1[i], da_lq2[i], da_lk2[i], da_subln_g[i],
                                           lam_init, rows, cols, with_ctx)
        yb_l, yb_c = gqa_branch(bq_l, bk_l, bv_l, bq_c, bk_c, bv_c,
                                gq_qnorm_g[i], gq_knorm_g[i], rows, cols, with_ctx)
        yc_l = chunk_sgu(cu_l, cv_l, sg_ln_g[i], sg_ln_b[i], sg_w[i], sg_b[i])
        yd_l, yd_c = gla_branch(dq_l, dk_l, dv_l, drf_l, drb_l, dq_c, dk_c, dv_c, drf_c, drb_c,
                                gla_w2_f[i], gla_b_f[i], gla_w2_b[i], gla_b_b[i], gla_norm_g[i], with_ctx)

        y_l = jnp.concatenate([ya_l * jax.nn.silu(az_l), yb_l * jax.nn.silu(bz_l),
                               yc_l * jax.nn.silu(cz_l), yd_l * jax.nn.silu(dz_l)], axis=-1)
        xl = xl + gt_l[:, None] * (y_l @ w_out[i])
        if with_ctx:
            yc_c = chunk_sgu(cu_c, cv_c, sg_ln_g[i], sg_ln_b[i], sg_w[i], sg_b[i])
            y_c = jnp.concatenate([ya_c * jax.nn.silu(az_c), yb_c * jax.nn.silu(bz_c),
                                   yc_c * jax.nn.silu(cz_c), yd_c * jax.nn.silu(dz_c)], axis=-1)
            xc = xc + gt_c * (y_c @ w_out[i])
    return rms_norm(xl, final_norm_g)
```

```cpp
#include <hip/hip_runtime.h>
#include <hip/hip_cooperative_groups.h>
#include <cstdio>
#include <cstdint>
namespace cg = cooperative_groups;

typedef unsigned short bf16_t;
typedef float f32x4 __attribute__((ext_vector_type(4)));
typedef unsigned u32x4 __attribute__((ext_vector_type(4)));
typedef unsigned u32x2 __attribute__((ext_vector_type(2)));

constexpr int NTHREADS = 512;
constexpr int LDS_BYTES = 163840;
constexpr int LDS_RSTD = 131072, LDS_TAB = 139264, LDS_BIASU = 151584, LDS_QKN = 159776;
constexpr int DM = 1024, SEQ = 2048, NB = 16, CTXL = 256, DEPTH = 4;
constexpr int NLAT = NB * SEQ, NCTX = NB * CTXL, MROWS = NLAT + NCTX;
constexpr int PINW = 3360, NPROJ = 3584;
constexpr float EPS = 1e-6f;
constexpr float LOG2E = 1.4426950408889634f;
constexpr int C_AQ = 0, C_AK = 256, C_AV = 512, C_AZ = 768, C_BQ = 1024, C_BK = 1280, C_BV = 1408, C_BZ = 1536,
              C_CU = 1792, C_CV = 2048, C_CZ = 2304, C_DQ = 2560, C_DK = 2688, C_DV = 2816, C_DZ = 3072;
constexpr size_t MiB = 1u << 20;
constexpr size_t WS_CTL = 0, WS_MOD = 1 * MiB, WS_BIAS = 2 * MiB, WS_TAB = 3 * MiB, WS_SSP = 4 * MiB, WS_WTIN = 8 * MiB, WS_WTOUT = 36 * MiB,
                 WS_XC = 44 * MiB, WS_XS = 64 * MiB, WS_Y = 136 * MiB, WS_PROJ = 208 * MiB, WS_GATE = 460 * MiB, WS_WG = 496 * MiB, WS_DVEC = 500 * MiB, WS_END = 502 * MiB;

struct Params {
  const float *x, *c, *ctx, *c_ctx, *ada_w, *ada_b, *norm_g, *w_in, *lq1, *lk1, *lq2, *lk2, *subln_g, *qn_g, *kn_g,
      *ln_g, *ln_b, *sg_w, *sg_b, *w2_f, *b_f, *w2_b, *b_b, *gla_g, *w_out, *final_g;
  float* out;
  unsigned char* ws;
};
constexpr int T_COSA = 0, T_SINA = 512, T_COSB = 1024, T_SINB = 2048, T_LAM = 3072, T_LAMI = 3076;
constexpr size_t WS_PV = WS_TAB + 16384, WS_SGW = WS_TAB + 65536;
constexpr int PV_SUBLN = 0, PV_QN = 256, PV_KN = 512, PV_GLAG = 768, PV_LNG = 1024, PV_LNB = 2048, PV_SGB = 3072, PV_NORMG = 5120, PV_TOTAL = 9216;
#define PVEC(P) ((const float*)((P).ws + WS_PV))

__device__ __forceinline__ unsigned f2bf(float f) { unsigned u = __builtin_bit_cast(unsigned, f); return (u + 0x7fffu + ((u >> 16) & 1u)) >> 16; }
typedef float f32x2_c __attribute__((ext_vector_type(2))); typedef __bf16 bf16x2_c __attribute__((ext_vector_type(2)));
__device__ __forceinline__ unsigned pk2(float lo, float hi) { const f32x2_c v = {lo, hi}; return __builtin_bit_cast(unsigned, __builtin_convertvector(v, bf16x2_c)); }
__device__ __forceinline__ float bflo(unsigned w) { return __builtin_bit_cast(float, w << 16); }
__device__ __forceinline__ float bfhi(unsigned w) { return __builtin_bit_cast(float, w & 0xffff0000u); }
__device__ __forceinline__ float bf2f(bf16_t h) { return __builtin_bit_cast(float, (unsigned)h << 16); }
__device__ __forceinline__ float wave_sum(float v) {
#pragma unroll
  for (int o = 1; o < 64; o <<= 1) v += __shfl_xor(v, o);
  return v;
}
__device__ __forceinline__ float siluf(float v) { return v * __builtin_amdgcn_rcpf(1.f + __expf(-v)); }
__device__ __forceinline__ int vi_now() { int bx = (int)blockIdx.x; asm volatile("" : "+s"(bx)); return (bx & 7) * 32 + (bx >> 3); }
__device__ __forceinline__ int tid_now() { int t = threadIdx.x; asm volatile("" : "+v"(t)); return t; }

__device__ __forceinline__ int colmap(int n) {
  const int pn = n >> 8, p = n & 255;
  if (pn <= 1) { const int e = p & 31, s = e >> 4, w = e & 15; return (n & ~31) + s * 16 + (w >> 1) + 8 * (w & 1); }
  if (pn == 4 || pn == 5) {
    const int bj = p >> 7, wc = (p >> 5) & 3, e = p & 31;
    if (pn == 4) return C_BQ + wc * 64 + bj * 32 + (e >> 1) + 16 * (e & 1);
    if (wc < 2) return C_BK + wc * 64 + bj * 32 + (e >> 1) + 16 * (e & 1);
    return C_BV + (wc - 2) * 64 + bj * 32 + e;
  }
  return n;
}
__device__ __forceinline__ float weff(const Params& P, int i, int k, int n) {
  const float* wrow = P.w_in + ((size_t)i * DM + k) * PINW;
  if (n < 3328) return wrow[colmap(n)];
  return ((float*)(P.ws + WS_WG))[((size_t)i * DM + k) * 256 + (n - 3328)];
}
__device__ __forceinline__ void p0_fold(const Params& P) {
  const int gt = blockIdx.x * NTHREADS + threadIdx.x, NG = gridDim.x * NTHREADS;
  for (int idx = gt; idx < DEPTH * DM * 256; idx += NG) {
    const int p = idx & 255, k = (idx >> 8) & 1023, i = idx >> 18, dir = p >> 7, j = p & 127;
    const float* w2 = (dir ? P.w2_b : P.w2_f) + (size_t)i * 16 * 128 + j;
    const float* r = P.w_in + ((size_t)i * DM + k) * PINW + 3328 + dir * 16;
    float s = 0.f;
#pragma unroll
    for (int q = 0; q < 16; ++q) s += r[q] * w2[q * 128];
    ((float*)(P.ws + WS_WG))[idx] = s;
  }
}

__device__ __forceinline__ void p0_mod(const Params& P, float* ldsf) {
  float* sc = ldsf;
  float* red = ldsf + 17 * 1024;
  const int tid = threadIdx.x;
  for (int u = blockIdx.x; u < 192; u += gridDim.x) {
    __syncthreads();
    for (int idx = tid; idx < 17 * 1024; idx += NTHREADS) { const int bb = idx >> 10, k = idx & 1023; const float c = bb < 16 ? P.c[bb * 1024 + k] : P.c_ctx[k]; sc[idx] = c / (1.f + expf(-c)); }
    __syncthreads();
    const int kc = tid >> 6, cl = tid & 63; const int cgl = u * 64 + cl; const int i = cgl / 3072, col = cgl % 3072;
    float acc[17];
#pragma unroll
    for (int bb = 0; bb < 17; ++bb) acc[bb] = 0.f;
    const float* w = P.ada_w + ((size_t)i * 1024 + kc * 128) * 3072 + col;
#pragma unroll 8
    for (int k = 0; k < 128; ++k) { const float wv = w[(size_t)k * 3072];
#pragma unroll
      for (int bb = 0; bb < 17; ++bb) acc[bb] += sc[bb * 1024 + kc * 128 + k] * wv; }
#pragma unroll
    for (int bb = 0; bb < 17; ++bb) red[(kc * 17 + bb) * 64 + cl] = acc[bb];
    __syncthreads();
    for (int idx = tid; idx < 17 * 64; idx += NTHREADS) { const int bb = idx >> 6, c2 = idx & 63; float s = 0.f;
#pragma unroll
      for (int q = 0; q < 8; ++q) s += red[(q * 17 + bb) * 64 + c2];
      const int cg2 = u * 64 + c2; const int i2 = cg2 / 3072, col2 = cg2 % 3072; ((float*)(P.ws + WS_MOD))[(size_t)(i2 * 17 + bb) * 3072 + col2] = s + P.ada_b[i2 * 3072 + col2]; }
  }
  __syncthreads();
}
__device__ __forceinline__ void p0_tables(const Params& P) {
  { const int gt = blockIdx.x * NTHREADS + threadIdx.x, NG = gridDim.x * NTHREADS; float* pv = (float*)(P.ws + WS_PV);
    for (int i = gt; i < PV_TOTAL; i += NG) { float v;
      if (i < PV_QN) v = P.subln_g[i]; else if (i < PV_KN) v = P.qn_g[i - PV_QN]; else if (i < PV_GLAG) v = P.kn_g[i - PV_KN]; else if (i < PV_LNG) v = P.gla_g[i - PV_GLAG];
      else if (i < PV_LNB) v = P.ln_g[i - PV_LNG]; else if (i < PV_SGB) v = P.ln_b[i - PV_LNB]; else if (i < PV_NORMG) v = P.sg_b[i - PV_SGB]; else v = P.norm_g[i - PV_NORMG];
      pv[i] = v; }
    bf16_t* sw = (bf16_t*)(P.ws + WS_SGW);
    for (int i = gt; i < DEPTH * 4 * 128 * 128 / 2; i += NG) { const float2 w = ((const float2*)P.sg_w)[i]; ((unsigned*)sw)[i] = pk2(w.x, w.y); } }
  if (blockIdx.x != gridDim.x - 1) return;
  const int tid = threadIdx.x;
  { const int pos = tid >> 3, j = tid & 7; const float inv = powf(10000.f, -(float)j / 8.f); const float a = (float)pos * inv; ((float*)(P.ws + WS_TAB))[T_COSA + tid] = cosf(a); ((float*)(P.ws + WS_TAB))[T_SINA + tid] = sinf(a); }
  for (int idx = tid; idx < 1024; idx += NTHREADS) { const int pos = idx >> 4, j = idx & 15; const float inv = powf(10000.f, -(float)j / 16.f); const float a = (float)pos * inv; ((float*)(P.ws + WS_TAB))[T_COSB + idx] = cosf(a); ((float*)(P.ws + WS_TAB))[T_SINB + idx] = sinf(a); }
  if (tid < 4) { float s1 = 0.f, s2 = 0.f; for (int d = 0; d < 32; ++d) { s1 += P.lq1[tid * 32 + d] * P.lk1[tid * 32 + d]; s2 += P.lq2[tid * 32 + d] * P.lk2[tid * 32 + d]; }
    const float li = (float)(0.8 - 0.6 * exp(-0.3 * (double)tid)); ((float*)(P.ws + WS_TAB))[T_LAM + tid] = expf(s1) - expf(s2) + li; ((float*)(P.ws + WS_TAB))[T_LAMI + tid] = li; }
}
template <int PART>
__device__ __forceinline__ void p0_weights(const Params& P, float* ldsf, int l0, int l1, int b0) {
  const int tid = tid_now(), lane = tid & 63, wave = tid >> 6;
  float* scr = ldsf + wave * (64 * 33);
  if ((int)blockIdx.x < b0) return;
  const int gw = ((int)blockIdx.x - b0) * 8 + wave, NGW = ((int)gridDim.x - b0) * 8;
  constexpr int I_IN = 16 * (NPROJ / 32), I_OUT = 16 * (DM / 32);
  const int NIT = (l1 - l0) * (I_IN + I_OUT);
  for (int it = gw; it < NIT; it += NGW) {
    const int i = l0 + it / (I_IN + I_OUT); int r = it % (I_IN + I_OUT);
    const bool isin = r < I_IN; if (!isin) r -= I_IN;
    const int nblk = isin ? NPROJ / 32 : DM / 32; const int kb = r / nblk, nb = r % nblk, k0 = 64 * kb, n0 = 32 * nb;
    if (PART != 2 && (isin && n0 >= 3328) != (PART == 1)) continue;
#pragma unroll 8
    for (int q = 0; q < 32; ++q) { const int kk = 2 * q + (lane >> 5), nn = lane & 31;
      scr[kk * 33 + nn] = isin ? weff(P, i, k0 + kk, n0 + nn) : P.w_out[((size_t)i * DM + k0 + kk) * DM + n0 + nn]; }
    asm volatile("s_waitcnt lgkmcnt(0)" ::: "memory");
    const int c = lane & 7;
    bf16_t* WT = isin ? ((bf16_t*)(P.ws + WS_WTIN)) + (size_t)i * NPROJ * DM : ((bf16_t*)(P.ws + WS_WTOUT)) + (size_t)i * DM * DM;
#pragma unroll
    for (int j = 0; j < 4; ++j) { const int n = (lane >> 3) + 8 * j; const float* s = scr + (8 * c) * 33 + n;
      u32x4 o; o.x = pk2(s[0 * 33], s[1 * 33]); o.y = pk2(s[2 * 33], s[3 * 33]); o.z = pk2(s[4 * 33], s[5 * 33]); o.w = pk2(s[6 * 33], s[7 * 33]);
      *(u32x4*)(WT + (size_t)(n0 + n) * DM + k0 + 8 * c) = o; }
    asm volatile("s_waitcnt lgkmcnt(0)" ::: "memory");
  }
}
__device__ __forceinline__ void p0_bias(const Params& P, float* ldsf, int l0, int l1, int b0) {
  float* sh = ldsf;
  float* red = ldsf + 17 * 1024;
  const int tid = tid_now();
  if ((int)blockIdx.x < b0) return;
  for (int u = (int)blockIdx.x - b0; u < (l1 - l0) * 56; u += (int)gridDim.x - b0) {
    const int i = l0 + u / 56, nb = u % 56;
    __syncthreads();
    for (int idx = tid; idx < 17 * 1024; idx += NTHREADS) { const int bb = idx >> 10, k = idx & 1023; sh[idx] = ((float*)(P.ws + WS_MOD))[(size_t)(i * 17 + bb) * 3072 + k]; }
    __syncthreads();
    const int kc = tid >> 6, cl = tid & 63; const int n = nb * 64 + cl;
    float acc[17];
#pragma unroll
    for (int bb = 0; bb < 17; ++bb) acc[bb] = 0.f;
#pragma unroll 8
    for (int k = 0; k < 128; ++k) { const float wv = weff(P, i, kc * 128 + k, n);
#pragma unroll
      for (int bb = 0; bb < 17; ++bb) acc[bb] += sh[bb * 1024 + kc * 128 + k] * wv; }
#pragma unroll
    for (int bb = 0; bb < 17; ++bb) red[(kc * 17 + bb) * 64 + cl] = acc[bb];
    __syncthreads();
    for (int idx = tid; idx < 17 * 64; idx += NTHREADS) { const int bb = idx >> 6, c2 = idx & 63; float s = 0.f;
#pragma unroll
      for (int q = 0; q < 8; ++q) s += red[(q * 17 + bb) * 64 + c2];
      const int n2 = nb * 64 + c2;
      if (n2 >= 3328) { const int p = n2 - 3328; s += (p >> 7) ? P.b_b[i * 128 + (p & 127)] : P.b_f[i * 128 + (p & 127)]; }
      ((float*)(P.ws + WS_BIAS))[(size_t)(i * 17 + bb) * NPROJ + n2] = s; }
  }
  __syncthreads();
}
__device__ __forceinline__ void p0_xs(const Params& P) {
  const int tid = threadIdx.x, lane = tid & 63, wave = tid >> 6;
  const int gw = blockIdx.x * 8 + wave, NGW = gridDim.x * 8;
  f32x4 g[4];
#pragma unroll
  for (int j = 0; j < 4; ++j) g[j] = *(const f32x4*)(P.norm_g + 4 * (lane + 64 * j));
  for (int row0 = gw * 2; row0 < MROWS; row0 += NGW * 2) {
    const float* src = row0 < NLAT ? P.x + (size_t)row0 * DM : P.ctx + (size_t)(row0 - NLAT) * DM;
    const int bb = row0 < NLAT ? (row0 >> 11) : 16;
    const float* sc = ((float*)(P.ws + WS_MOD)) + (size_t)bb * 3072 + 1024;
    f32x4 v[2][4], sv[4];
#pragma unroll
    for (int j = 0; j < 4; ++j) { const int k = 4 * (lane + 64 * j); sv[j] = *(const f32x4*)(sc + k); v[0][j] = __builtin_nontemporal_load((const f32x4*)(src + k)); v[1][j] = __builtin_nontemporal_load((const f32x4*)(src + DM + k)); }
#pragma unroll
    for (int r = 0; r < 2; ++r) { float ss = 0.f;
#pragma unroll
      for (int j = 0; j < 4; ++j) { const int k = 4 * (lane + 64 * j); const f32x4 x = v[r][j], gg = g[j], s = sv[j];
        ss += x.x * x.x + x.y * x.y + x.z * x.z + x.w * x.w;
        u32x2 o; o.x = pk2(x.x * gg.x * (1.f + s.x), x.y * gg.y * (1.f + s.y)); o.y = pk2(x.z * gg.z * (1.f + s.z), x.w * gg.w * (1.f + s.w));
        *(u32x2*)(((bf16_t*)(P.ws + WS_XS)) + (size_t)(row0 + r) * DM + k) = o; }
      ss = wave_sum(ss);
      if (lane < 16) ((float*)(P.ws + WS_SSP))[(size_t)(row0 + r) * 16 + lane] = lane == 0 ? ss : 0.f; }
  }
}

namespace pg8 {
#define PG8_LAS __attribute__((address_space(3)))
typedef unsigned short bf16_t;
typedef short bf16x8 __attribute__((ext_vector_type(8)));
typedef float f32x4 __attribute__((ext_vector_type(4)));
typedef unsigned u32x4 __attribute__((ext_vector_type(4)));
constexpr int BM = 256, BK = 64, HALF = 128, HTB = HALF * BK * 2  , STAGE_BYTES = 8 * HTB, NXCD = 8, WGM = 8;

__host__ __device__ __forceinline__ int lds_byte(int r, int c) { const int st = (r >> 4) * 2 + (c >> 5), rr = r & 15, cc = c & 31, ob = rr * 64 + cc * 2; return st * 1024 + (ob ^ (((ob >> 9) & 1) << 5)); }
__host__ __device__ __forceinline__ void stage_rc(int b, int& R, int& C) { const int st = b / 1024, sb = b % 1024, swz = sb ^ (((sb >> 9) & 1) << 5); R = (st >> 1) * 16 + swz / 64; C = (st & 1) * 32 + (swz % 64) / 2; }
__host__ __device__ __forceinline__ int perm32(int rho) { const int n = rho >> 4, i = rho & 15; return 8 * (i >> 2) + 4 * n + (i & 3); }

struct Unit { int pm, pn; };
struct Gemm { const bf16_t* A; const bf16_t* Bt; int M, N, K; };

struct StaticOrder {
    int nM, nN, nwg, G, c;
    __host__ __device__ void init(int M, int N, int G_, int c_) { nM = M / BM; nN = N / BM; nwg = nM * nN; G = G_; c = c_; }
    __host__ __device__ bool next(int i, Unit& u) const {
        const long L = (long)i * G + c; if (L >= nwg) return false;
        int wgid = (int)L; { const int q = nwg / NXCD, r = nwg % NXCD, xcd = wgid % NXCD, off = wgid / NXCD; wgid = (xcd < r ? xcd * (q + 1) : r * (q + 1) + (xcd - r) * q) + off; }
        const int nig = WGM * nN, gid = wgid / nig, fm = gid * WGM, gsz = (nM - fm) < WGM ? (nM - fm) : WGM;
        u.pm = fm + ((wgid % nig) % gsz); u.pn = (wgid % nig) / gsz; return true;
    }
    __device__ __forceinline__ void a_ready(const Unit&) const {}
    __device__ __forceinline__ void done(const Unit&) const {}
};
struct XcdOrder {
    int nMl, nN, G, c, rb0, cb0, nlat;
    __device__ __forceinline__ void init(int nMl_, int nN_, int G_, int c_, int rb0_, int cb0_, int nlat_) { nMl = nMl_; nN = nN_; G = G_; c = c_; rb0 = rb0_; cb0 = cb0_; nlat = nlat_; }
    __device__ __forceinline__ bool next(int i, Unit& u) const {
        const int L = i * G + c; if (L >= nMl * nN) return false;
        const int nig = WGM * nN, gid = L / nig, fm = gid * WGM, gsz = (nMl - fm) < WGM ? (nMl - fm) : WGM;
        const int pl = fm + ((L % nig) % gsz); u.pn = (L % nig) / gsz; u.pm = pl < nlat ? rb0 + pl : cb0 + (pl - nlat); return true;
    }
    __device__ __forceinline__ void a_ready(const Unit&) const {}
    __device__ __forceinline__ void done(const Unit&) const {}
};


template <class Epi, class Sched, bool ALIGN_EPI = false, bool SP2 = false>
__device__ __forceinline__ void gemm_phase(PG8_LAS unsigned char* lds, const Gemm g, const Sched& S, const Epi& E) {
    const int tid = tid_now(), wid = __builtin_amdgcn_readfirstlane(tid >> 6), lane = tid & 63, wr = wid >> 2, wc = wid & 3, fr = lane & 15, fq = lane >> 4;
    const int K = g.K, nt = K / BK;
    unsigned voffA[2], voffB[2];
#pragma unroll
    for (int i = 0; i < 2; ++i) { int R, C; stage_rc(tid * 16 + i * 8192, R, C); const int Rb = Epi::PERM ? ((R & ~31) + perm32(R & 31)) : R;
        voffA[i] = (unsigned)(R * K + C) * 2u; voffB[i] = (unsigned)(Rb * K + C) * 2u; }
    const size_t kstep = (size_t)(BK * 2);
    const size_t hstep = (size_t)HALF * K * 2;
    const size_t tstep = 2 * hstep;
    const unsigned ldsw = (unsigned)wid * 1024u;
    const int aoff = lds_byte(wr * 64 + fr, fq * 8), boff = lds_byte(wc * 32 + fr, fq * 8);
#define PG8_SA(b, h) (((b) * 2 + (h)) * HTB)
#define PG8_SB(b, h) ((4 + (b) * 2 + (h)) * HTB)
#define PG8_STAGE(bufoff, gbase, voff) do { _Pragma("unroll") for (int _i = 0; _i < 2; ++_i) \
        __builtin_amdgcn_global_load_lds((const unsigned*)((const char*)(gbase) + (voff)[_i]), (PG8_LAS unsigned*)(lds + (bufoff) + ldsw + _i * 8192), 16, 0, 0); } while (0)
#define PG8_LDA(dst, b, h) do { _Pragma("unroll") for (int m = 0; m < 4; ++m) _Pragma("unroll") for (int k = 0; k < 2; ++k) dst[m][k] = *(const PG8_LAS bf16x8*)(lds + PG8_SA(b, h) + aoff + m * 2048 + k * 1024); } while (0)
#define PG8_LDB(dst, b, h) do { _Pragma("unroll") for (int n = 0; n < 2; ++n) _Pragma("unroll") for (int k = 0; k < 2; ++k) dst[n][k] = *(const PG8_LAS bf16x8*)(lds + PG8_SB(b, h) + boff + n * 2048 + k * 1024); } while (0)
#define PG8_MMA(ai, bj, At, Bt) do { __builtin_amdgcn_s_setprio(1); _Pragma("unroll") for (int m = 0; m < 4; ++m) _Pragma("unroll") for (int n = 0; n < 2; ++n) _Pragma("unroll") for (int k = 0; k < 2; ++k) \
        acc[ai][bj][m][n] = __builtin_amdgcn_mfma_f32_16x16x32_bf16(Bt[n][k], At[m][k], acc[ai][bj][m][n], 0, 0, 0); __builtin_amdgcn_s_setprio(0); } while (0)
#define PG8_WAIT_V(n) asm volatile("s_waitcnt vmcnt(" #n ")" ::: "memory")
#define PG8_WAIT_L(n) asm volatile("s_waitcnt lgkmcnt(" #n ")" ::: "memory")
#define PG8_BAR __builtin_amdgcn_s_barrier()
#define PG8_SCHED __builtin_amdgcn_sched_barrier(0)
    Unit cur, nxt; int ui = 0;
    if (!S.next(0, cur)) return;
    f32x4 acc[2][2][4][2];
#pragma unroll
    for (int a = 0; a < 2; ++a)
#pragma unroll
        for (int b = 0; b < 2; ++b)
#pragma unroll
            for (int m = 0; m < 4; ++m)
#pragma unroll
                for (int n = 0; n < 2; ++n) acc[a][b][m][n] = (f32x4){0.f, 0.f, 0.f, 0.f};
    bf16x8 At[4][2], B0[2][2], B1[2][2];
    const char* cA = (const char*)g.A + (size_t)cur.pm * tstep; const char* cB = (const char*)g.Bt + (size_t)cur.pn * tstep;
    S.a_ready(cur);
    if constexpr (SP2) {
        PG8_STAGE(PG8_SB(0, 0), cB, voffB); PG8_STAGE(PG8_SB(0, 1), cB + hstep, voffB); PG8_STAGE(PG8_SA(0, 0), cA, voffA); PG8_STAGE(PG8_SA(0, 1), cA + hstep, voffA);
        if (wr == 1) PG8_BAR;
        PG8_WAIT_V(2); PG8_BAR;
        PG8_STAGE(PG8_SB(1, 0), cB + kstep, voffB); PG8_STAGE(PG8_SA(1, 0), cA + kstep, voffA); PG8_STAGE(PG8_SB(1, 1), cB + hstep + kstep, voffB);
        PG8_WAIT_V(6); PG8_BAR;
    } else {
        PG8_STAGE(PG8_SB(0, 0), cB, voffB); PG8_STAGE(PG8_SA(0, 0), cA, voffA); PG8_STAGE(PG8_SB(0, 1), cB + hstep, voffB); PG8_STAGE(PG8_SA(0, 1), cA + hstep, voffA);
        if (wr == 1) PG8_BAR;
        PG8_WAIT_V(4); PG8_BAR;
        PG8_STAGE(PG8_SB(1, 0), cB + kstep, voffB); PG8_STAGE(PG8_SA(1, 0), cA + kstep, voffA); PG8_STAGE(PG8_SB(1, 1), cB + hstep + kstep, voffB);
        PG8_WAIT_V(6); PG8_BAR;
    }
    for (;;) {
        const bool has_next = S.next(ui + 1, nxt);
        const char* nA = has_next ? (const char*)g.A + (size_t)nxt.pm * tstep : cA; const char* nB = has_next ? (const char*)g.Bt + (size_t)nxt.pn * tstep : cB;
        for (int t = 0; t < nt; t += 2) {
            const bool last = (t == nt - 2);
            const char* a1 = cA + (size_t)(t + 1) * kstep;
            const char* a2 = last ? nA : cA + (size_t)(t + 2) * kstep; const char* b2 = last ? nB : cB + (size_t)(t + 2) * kstep;
            const char* a3 = a2 + kstep; const char* b3 = b2 + kstep;
            if (last && has_next) S.a_ready(nxt);
            if constexpr (SP2) {
            PG8_LDB(B0, 0, 0); PG8_LDB(B1, 0, 1); PG8_SCHED; PG8_LDA(At, 0, 0); PG8_STAGE(PG8_SA(1, 1), a1 + hstep, voffA);
            PG8_WAIT_V(8); PG8_WAIT_L(0); PG8_BAR; PG8_MMA(0, 0, At, B0); PG8_MMA(0, 1, At, B1); PG8_BAR; PG8_SCHED;
            PG8_LDA(At, 0, 1); PG8_STAGE(PG8_SB(0, 0), b2, voffB); PG8_STAGE(PG8_SB(0, 1), b2 + hstep, voffB); PG8_STAGE(PG8_SA(0, 0), a2, voffA);
            PG8_WAIT_V(8); PG8_WAIT_L(0); PG8_BAR; PG8_MMA(1, 0, At, B0); PG8_MMA(1, 1, At, B1); PG8_BAR; PG8_SCHED;
            PG8_LDB(B0, 1, 0); PG8_LDB(B1, 1, 1); PG8_SCHED; PG8_LDA(At, 1, 0); PG8_STAGE(PG8_SA(0, 1), a2 + hstep, voffA);
            PG8_WAIT_V(8); PG8_WAIT_L(0); PG8_BAR; PG8_MMA(0, 0, At, B0); PG8_MMA(0, 1, At, B1); PG8_BAR; PG8_SCHED;
            PG8_LDA(At, 1, 1); PG8_STAGE(PG8_SB(1, 0), b3, voffB); PG8_STAGE(PG8_SB(1, 1), b3 + hstep, voffB); PG8_STAGE(PG8_SA(1, 0), a3, voffA);
            PG8_WAIT_V(8); PG8_WAIT_L(0); PG8_BAR; PG8_MMA(1, 0, At, B0); PG8_MMA(1, 1, At, B1); PG8_BAR; PG8_SCHED;
            } else {
            PG8_LDB(B0, 0, 0); PG8_SCHED; PG8_LDA(At, 0, 0); PG8_STAGE(PG8_SA(1, 1), a1 + hstep, voffA);
            PG8_WAIT_L(8); PG8_BAR; PG8_WAIT_L(0); PG8_MMA(0, 0, At, B0); PG8_BAR; PG8_SCHED;
            PG8_LDB(B1, 0, 1); PG8_STAGE(PG8_SB(0, 0), b2, voffB);
            PG8_BAR; PG8_WAIT_L(0); PG8_MMA(0, 1, At, B1); PG8_BAR;
            PG8_LDA(At, 0, 1); PG8_STAGE(PG8_SA(0, 0), a2, voffA);
            PG8_BAR; PG8_WAIT_L(0); PG8_MMA(1, 0, At, B0); PG8_BAR; PG8_SCHED;
            PG8_STAGE(PG8_SB(0, 1), b2 + hstep, voffB);
            PG8_WAIT_V(6); PG8_BAR; PG8_MMA(1, 1, At, B1); PG8_BAR;
            PG8_LDB(B0, 1, 0); PG8_SCHED; PG8_LDA(At, 1, 0); PG8_STAGE(PG8_SA(0, 1), a2 + hstep, voffA);
            PG8_WAIT_L(8); PG8_BAR; PG8_WAIT_L(0); PG8_MMA(0, 0, At, B0); PG8_BAR; PG8_SCHED;
            PG8_LDB(B1, 1, 1); PG8_STAGE(PG8_SB(1, 0), b3, voffB);
            PG8_BAR; PG8_WAIT_L(0); PG8_MMA(0, 1, At, B1); PG8_BAR;
            PG8_LDA(At, 1, 1); PG8_STAGE(PG8_SA(1, 0), a3, voffA);
            PG8_BAR; PG8_WAIT_L(0); PG8_MMA(1, 0, At, B0); PG8_BAR; PG8_SCHED;
            PG8_STAGE(PG8_SB(1, 1), b3 + hstep, voffB);
            PG8_WAIT_V(6); PG8_BAR; PG8_MMA(1, 1, At, B1); PG8_BAR;
            }
        }
        if constexpr (ALIGN_EPI) { if (wr == 0) PG8_BAR; }
        if constexpr (!Epi::AFTER_DRAIN) { E(acc, cur, ui, wr, wc, fr, fq); S.done(cur); }
        if (!has_next) break;
#pragma unroll
        for (int a = 0; a < 2; ++a)
#pragma unroll
            for (int b = 0; b < 2; ++b)
#pragma unroll
                for (int m = 0; m < 4; ++m)
#pragma unroll
                    for (int n = 0; n < 2; ++n) acc[a][b][m][n] = (f32x4){0.f, 0.f, 0.f, 0.f};
        cur = nxt; cA = nA; cB = nB; ++ui;
        if constexpr (ALIGN_EPI) { if (wr == 1) PG8_BAR; }
    }
    PG8_WAIT_V(0);
    if constexpr (!ALIGN_EPI) { if (wr == 0) PG8_BAR; }
    PG8_BAR;
    if constexpr (Epi::AFTER_DRAIN) { E.fused(acc, cur, wr, wc, fr, fq, lds, wid, lane); S.done(cur); }
#undef PG8_SA
#undef PG8_SB
#undef PG8_STAGE
#undef PG8_LDA
#undef PG8_LDB
#undef PG8_MMA
#undef PG8_WAIT_V
#undef PG8_WAIT_L
#undef PG8_BAR
#undef PG8_SCHED
}
}

__device__ __forceinline__ void rope4(f32x4& v, const f32x4 cs  ) {
  const float a0 = v.x * cs.x - v.y * cs.y, b0 = v.x * cs.y + v.y * cs.x, a1 = v.z * cs.z - v.w * cs.w, b1 = v.z * cs.w + v.w * cs.z;
  v = (f32x4){a0, b0, a1, b1};
}
__device__ __forceinline__ float logsig(float x) { return fminf(x, 0.f) - __logf(1.f + __expf(-fabsf(x))); }
struct EpiIn {
  const Params& P; int layer; const float* lrstd; const float* ltab; const float* lbias; const float* lqkn;
  static constexpr bool PERM = true, AFTER_DRAIN = false;
  __device__ __forceinline__ void operator()(const f32x4 (&acc)[2][2][4][2], const pg8::Unit& u, int ui, int wr, int wc, int fr, int fq) const { (*this)(acc, u.pm, u.pn, ui, wr, wc, fr, fq); }
  template <int KIND>
  __device__ __forceinline__ void rows(const f32x4 (&acc)[2][2][4][2], int pm, int pn, int ui, int wr, int wc, int fr, int fq) const {
    asm volatile("" : "+v"(fr), "+v"(fq));
    const bool lat = pm < 128; const int bb = lat ? (pm >> 3) : 16;
    const float* bias = lbias + ui * 256; (void)bb;
    const int cw = 32 * wc + 8 * fq;
    f32x4 bv[2][2];
#pragma unroll
    for (int bj = 0; bj < 2; ++bj)
#pragma unroll
      for (int n = 0; n < 2; ++n) bv[bj][n] = *(const f32x4*)(bias + 128 * bj + cw + 4 * n);
    const bool isnorm = KIND == 1 && ((pn == 4) || (wc < 2));
    const float* gsrc = lqkn + (pn == 4 ? 0 : 64);
#pragma unroll
    for (int ai = 0; ai < 2; ++ai)
#pragma unroll
      for (int m = 0; m < 4; ++m) {
        const int row = pm * 256 + 128 * ai + 64 * wr + 16 * m + fr;
        const float rstd = lrstd[ui * 256 + 128 * ai + 64 * wr + 16 * m + fr];
        f32x4 v[2][2];
#pragma unroll
        for (int bj = 0; bj < 2; ++bj)
#pragma unroll
          for (int n = 0; n < 2; ++n) v[bj][n] = acc[ai][bj][m][n] * rstd + bv[bj][n];
        const int t = row & 2047;
        bf16_t* prow = ((bf16_t*)(P.ws + WS_PROJ)) + (size_t)row * NPROJ;
        if (KIND == 0) {
          if (lat) { const int pos = (fq >> 1) == 0 ? (t >> 6) : (t & 63);
#pragma unroll
            for (int bj = 0; bj < 2; ++bj)
#pragma unroll
              for (int n = 0; n < 2; ++n) { const int j = 4 * (fq & 1) + 2 * n; const float* tc = ltab + T_COSA + pos * 8 + j; const float* ts = ltab + T_SINA + pos * 8 + j;
                rope4(v[bj][n], (f32x4){tc[0], ts[0], tc[1], ts[1]}); } }
          const float sc = pn == 0 ? 0.17677669529663687f * LOG2E : 1.f;
#pragma unroll
          for (int bj = 0; bj < 2; ++bj) { const f32x4 a = v[bj][0] * sc, b = v[bj][1] * sc;
            *(u32x4*)(prow + pn * 256 + 128 * bj + cw) = (u32x4){pk2(a.x, a.y), pk2(a.z, a.w), pk2(b.x, b.y), pk2(b.z, b.w)}; }
        } else if (KIND == 1) {
          if (isnorm) {
            float hs = 0.f;
#pragma unroll
            for (int bj = 0; bj < 2; ++bj)
#pragma unroll
              for (int n = 0; n < 2; ++n) hs += (v[bj][n].x * v[bj][n].x + v[bj][n].y * v[bj][n].y) + (v[bj][n].z * v[bj][n].z + v[bj][n].w * v[bj][n].w);
            hs += __shfl_xor(hs, 16); hs += __shfl_xor(hs, 32);
            const float hr = rsqrtf(hs * (1.f / 64.f) + EPS);
#pragma unroll
            for (int bj = 0; bj < 2; ++bj)
#pragma unroll
              for (int n = 0; n < 2; ++n) { const int j0 = bj * 32 + 4 * fq + 2 * n; v[bj][n] = v[bj][n] * hr * (f32x4){gsrc[j0], gsrc[j0 + 16], gsrc[j0 + 1], gsrc[j0 + 17]}; }
            if (lat) {
#pragma unroll
              for (int bj = 0; bj < 2; ++bj) { const int pos = bj == 0 ? (t >> 6) : (t & 63);
#pragma unroll
                for (int n = 0; n < 2; ++n) { const int j = 4 * fq + 2 * n; const float* tc = ltab + T_COSB + pos * 16 + j; const float* ts = ltab + T_SINB + pos * 16 + j;
                  rope4(v[bj][n], (f32x4){tc[0], ts[0], tc[1], ts[1]}); } } }
          }
          const float sc = pn == 4 ? 0.125f * LOG2E : 1.f;
          const int dbase = pn == 4 ? C_BQ + wc * 64 : (wc < 2 ? C_BK + wc * 64 : C_BV + (wc - 2) * 64);
#pragma unroll
          for (int bj = 0; bj < 2; ++bj) { const f32x4 a = v[bj][0] * sc, b = v[bj][1] * sc;
            *(u32x4*)(prow + dbase + bj * 32 + 8 * fq) = (u32x4){pk2(a.x, a.y), pk2(a.z, a.w), pk2(b.x, b.y), pk2(b.z, b.w)}; }
        } else if (KIND == 2) {
#pragma unroll
          for (int bj = 0; bj < 2; ++bj) { float* grow = ((float*)(P.ws + WS_GATE)) + (((size_t)((row >> 6) * 4 + wc) * 2 + bj) * 64 + (row & 63)) * 32 + 8 * fq;
#pragma unroll
            for (int n = 0; n < 2; ++n) { const f32x4 x = v[bj][n];
              *(f32x4*)(grow + 4 * n) = (f32x4){logsig(x.x) * 0.0625f, logsig(x.y) * 0.0625f, logsig(x.z) * 0.0625f, logsig(x.w) * 0.0625f}; } }
        } else {
          const bool sil = (pn == 3) || (pn == 6) || (pn == 9) || (pn == 12);
#pragma unroll
          for (int bj = 0; bj < 2; ++bj) { f32x4 a = v[bj][0], b = v[bj][1];
            if (sil) { a = (f32x4){siluf(a.x), siluf(a.y), siluf(a.z), siluf(a.w)}; b = (f32x4){siluf(b.x), siluf(b.y), siluf(b.z), siluf(b.w)}; }
            if (pn == 10 && bj == 0) { a = a * 0.17677669529663687f; b = b * 0.17677669529663687f; }
            *(u32x4*)(prow + pn * 256 + 128 * bj + cw) = (u32x4){pk2(a.x, a.y), pk2(a.z, a.w), pk2(b.x, b.y), pk2(b.z, b.w)}; }
        }
      }
  }
  __device__ __forceinline__ void operator()(const f32x4 (&acc)[2][2][4][2], int pm, int pn, int ui, int wr, int wc, int fr, int fq) const {
    if (pn <= 1) rows<0>(acc, pm, pn, ui, wr, wc, fr, fq);
    else if (pn == 4 || pn == 5) rows<1>(acc, pm, pn, ui, wr, wc, fr, fq);
    else if (pn == 13) rows<2>(acc, pm, pn, ui, wr, wc, fr, fq);
    else rows<3>(acc, pm, pn, ui, wr, wc, fr, fq);
  }
};
template <bool F32IN, bool F32OUT> struct EpiOut {
  const Params& P; int layer;
  static constexpr bool PERM = true, AFTER_DRAIN = false;
  __device__ __forceinline__ void operator()(const f32x4 (&acc)[2][2][4][2], const pg8::Unit& u, int ui, int wr, int wc, int fr, int fq) const { (*this)(acc, u.pm, u.pn, wr, wc, fr, fq); }
  __device__ __forceinline__ void operator()(const f32x4 (&acc)[2][2][4][2], int pm, int pn, int wr, int wc, int fr, int fq) const {
    asm volatile("" : "+v"(fr), "+v"(fq));
    const bool lat = pm < 128; const int bb = lat ? (pm >> 3) : 16;
    constexpr bool hn = !F32OUT;
    const float* gate = ((float*)(P.ws + WS_MOD)) + (size_t)(layer * 17 + bb) * 3072 + 2048 + pn * 256;
    const float* ng = PVEC(P) + PV_NORMG + (hn ? layer + 1 : layer) * DM + pn * 256;
    const float* nsc = ((float*)(P.ws + WS_MOD)) + (size_t)((hn ? layer + 1 : layer) * 17 + bb) * 3072 + 1024 + pn * 256;
    const int cw = 32 * wc + 8 * fq;
    f32x4 gv[2][2], cf[2][2];
#pragma unroll
    for (int bj = 0; bj < 2; ++bj)
#pragma unroll
      for (int n = 0; n < 2; ++n) { const int c0 = 128 * bj + cw + 4 * n; gv[bj][n] = *(const f32x4*)(gate + c0); if (hn) cf[bj][n] = *(const f32x4*)(ng + c0) * (*(const f32x4*)(nsc + c0) + 1.f); }
    const bf16_t* rb = lat ? (const bf16_t*)P.out + (size_t)(layer & 1) * NLAT * DM : (const bf16_t*)(P.ws + WS_XC) + (size_t)(layer & 1) * NCTX * DM;
    bf16_t* wb = lat ? (bf16_t*)P.out + (size_t)((layer + 1) & 1) * NLAT * DM : (bf16_t*)(P.ws + WS_XC) + (size_t)((layer + 1) & 1) * NCTX * DM;
    constexpr int RB = F32IN ? 2 : 4;
#pragma unroll
    for (int am = 0; am < 8 / RB; ++am) { const int ai = (am * RB) >> 2, mb = (am * RB) & 3;
      f32x4 xf[F32IN ? RB : 1][2][2]; u32x4 xh[F32IN ? 1 : RB][2];
#pragma unroll
      for (int mm = 0; mm < RB; ++mm) { const int row = pm * 256 + 128 * ai + 64 * wr + 16 * (mb + mm) + fr; const size_t rl = lat ? (size_t)row : (size_t)(row - NLAT);
        if (F32IN) { const float* xo = lat ? P.x + rl * DM : P.ctx + rl * DM;
#pragma unroll
          for (int bj = 0; bj < 2; ++bj)
#pragma unroll
            for (int n = 0; n < 2; ++n) xf[mm][bj][n] = __builtin_nontemporal_load((const f32x4*)(xo + pn * 256 + 128 * bj + cw + 4 * n)); }
        else {
#pragma unroll
          for (int bj = 0; bj < 2; ++bj) xh[mm][bj] = __builtin_nontemporal_load((const u32x4*)(rb + rl * DM + pn * 256 + 128 * bj + cw)); } }
#pragma unroll
      for (int mm = 0; mm < RB; ++mm) {
        const int m = mb + mm; const int row = pm * 256 + 128 * ai + 64 * wr + 16 * m + fr; const size_t rl = lat ? (size_t)row : (size_t)(row - NLAT);
        float ssq = 0.f;
#pragma unroll
        for (int bj = 0; bj < 2; ++bj) { f32x4 xn[2];
          if (F32IN) { xn[0] = xf[mm][bj][0]; xn[1] = xf[mm][bj][1]; }
          else { const u32x4 w = xh[mm][bj]; xn[0] = (f32x4){bflo(w.x), bfhi(w.x), bflo(w.y), bfhi(w.y)}; xn[1] = (f32x4){bflo(w.z), bfhi(w.z), bflo(w.w), bfhi(w.w)}; }
#pragma unroll
          for (int n = 0; n < 2; ++n) { xn[n] = xn[n] + gv[bj][n] * acc[ai][bj][m][n]; ssq += (xn[n].x * xn[n].x + xn[n].y * xn[n].y) + (xn[n].z * xn[n].z + xn[n].w * xn[n].w); }
          const int c = pn * 256 + 128 * bj + cw;
          if (F32OUT) { *(u32x4*)(((bf16_t*)(P.ws + WS_PROJ)) + (rl >> 12) * ((size_t)4096 * NPROJ) + (rl & 4095) * DM + c) = (u32x4){pk2(xn[0].x, xn[0].y), pk2(xn[0].z, xn[0].w), pk2(xn[1].x, xn[1].y), pk2(xn[1].z, xn[1].w)}; }
          else { *(u32x4*)(wb + rl * DM + c) = (u32x4){pk2(xn[0].x, xn[0].y), pk2(xn[0].z, xn[0].w), pk2(xn[1].x, xn[1].y), pk2(xn[1].z, xn[1].w)};
            const f32x4 a = xn[0] * cf[bj][0], b = xn[1] * cf[bj][1];
            *(u32x4*)(((bf16_t*)(P.ws + WS_XS)) + (size_t)row * DM + c) = (u32x4){pk2(a.x, a.y), pk2(a.z, a.w), pk2(b.x, b.y), pk2(b.z, b.w)}; } }
        ssq += __shfl_xor(ssq, 16); ssq += __shfl_xor(ssq, 32);
        if (fq == 0) ((float*)(P.ws + WS_SSP))[(size_t)row * 16 + pn * 4 + wc] = ssq;
      }
      asm volatile("" ::: "memory");
    }
  }
};

__device__ __forceinline__ void final_norm(const Params& P) {
  const int tid = tid_now(), lane = tid & 63, wave = tid >> 6;
  const bool aff = gridDim.x == 256;
  const int gw = aff ? (int)(blockIdx.x >> 3) * 8 + wave : (int)blockIdx.x * 8 + wave, NGW = aff ? 256 : (int)gridDim.x * 8;
  const int rbeg = aff ? (int)(blockIdx.x & 7) * 4096 : 0, rend = aff ? rbeg + 4096 : NLAT;
  f32x4 g[4];
#pragma unroll
  for (int j = 0; j < 4; ++j) g[j] = *(const f32x4*)(P.final_g + 4 * (lane + 64 * j));
  for (int row0 = rbeg + gw * 4; row0 < rend; row0 += NGW * 4) {
    u32x2 v[4][4]; float ss[4];
#pragma unroll
    for (int r = 0; r < 4; ++r) { ss[r] = lane < 16 ? ((float*)(P.ws + WS_SSP))[(size_t)(row0 + r) * 16 + lane] : 0.f;
#pragma unroll
      for (int j = 0; j < 4; ++j) v[r][j] = __builtin_nontemporal_load((const u32x2*)(((const bf16_t*)(P.ws + WS_PROJ)) + (size_t)((row0 + r) >> 12) * ((size_t)4096 * NPROJ) + (size_t)((row0 + r) & 4095) * DM + 4 * (lane + 64 * j))); }
#pragma unroll
    for (int r = 0; r < 4; ++r) { const float rstd = rsqrtf(wave_sum(ss[r]) * (1.f / DM) + EPS);
#pragma unroll
      for (int j = 0; j < 4; ++j) { const f32x4 x = {bflo(v[r][j].x), bfhi(v[r][j].x), bflo(v[r][j].y), bfhi(v[r][j].y)}; __builtin_nontemporal_store(x * rstd * g[j], (f32x4*)(P.out + (size_t)(row0 + r) * DM + 4 * (lane + 64 * j))); } }
  }
}
namespace att {
using bf16x8=__attribute__((ext_vector_type(8)))short;
using s16x4=__attribute__((ext_vector_type(4)))short;
using f32x16=__attribute__((ext_vector_type(16)))float;
constexpr int NW=8,QBLK=32,QB=QBLK*NW,KVBLK=64,PITCH=NPROJ;
__device__ __forceinline__ int crow(int r,int hi){return (r&3)+8*(r>>2)+4*hi;}
#define SBAR() __builtin_amdgcn_sched_barrier(0)
constexpr int NSLOT=3, SLOTB=8192;
constexpr int LDS_K=0, LDS_V=NSLOT*SLOTB, LDS_WS=2*NSLOT*SLOTB, LDS_OST=LDS_WS+NW*64*4, LDS_BYTES_ATT=LDS_OST+NW*8192;
__device__ __forceinline__ void glds16(const void*gsrc,unsigned lds_dst){unsigned keep;
  asm volatile("s_mov_b32 %0, m0\n\ts_mov_b32 m0, %2\n\ts_nop 0\n\tglobal_load_lds_dwordx4 %1, off\n\ts_mov_b32 m0, %0":"=&s"(keep):"v"(gsrc),"s"(lds_dst):"memory");}
__device__ __forceinline__ float max3f(float a,float b,float c){float r;asm("v_max3_f32 %0, %1, %2, %3":"=v"(r):"v"(a),"v"(b),"v"(c));return r;}
__device__ __forceinline__ float max2f(float a,float b){float r;asm("v_max_f32_e32 %0, %1, %2":"=v"(r):"v"(a),"v"(b));return r;}
__device__ __forceinline__ float fadd_s(float a,float b){float r;asm("v_add_f32_e32 %0, %1, %2":"=v"(r):"v"(a),"v"(b));return r;}
__device__ __forceinline__ float fsub_s(float a,float b){float r;asm("v_sub_f32_e32 %0, %1, %2":"=v"(r):"v"(a),"v"(b));return r;}
typedef float f32x2_t __attribute__((ext_vector_type(2))); typedef __bf16 bf16x2_t __attribute__((ext_vector_type(2)));
__device__ __forceinline__ unsigned cvtpk_s(float lo,float hi){f32x2_t v={lo,hi};bf16x2_t b=__builtin_convertvector(v,bf16x2_t);return __builtin_bit_cast(unsigned,b);}
#define WAIT_BAR(N) asm volatile("s_waitcnt vmcnt(" #N ") lgkmcnt(0)\n\ts_barrier":::"memory")
template<int ND> __device__ __forceinline__ void qkt(f32x16&p0,f32x16&p1,const char*Kslot,const bf16x8*qr,const f32x16&negm,int r32,int hi){
  const char*kb=Kslot+hi*1024+r32*16;
  #pragma unroll
  for(int d0=0;d0<ND;++d0){
    const bf16x8 b0=*reinterpret_cast<const bf16x8*>(kb+d0*2048);
    const bf16x8 b1=*reinterpret_cast<const bf16x8*>(kb+d0*2048+512);
    if(d0==0){p0=__builtin_amdgcn_mfma_f32_32x32x16_bf16(b0,qr[0],negm,0,0,0);p1=__builtin_amdgcn_mfma_f32_32x32x16_bf16(b1,qr[0],negm,0,0,0);}
    else{p0=__builtin_amdgcn_mfma_f32_32x32x16_bf16(b0,qr[d0],p0,0,0,0);p1=__builtin_amdgcn_mfma_f32_32x32x16_bf16(b1,qr[d0],p1,0,0,0);}}
}
typedef __attribute__((address_space(3))) const char* lds_cptr;
typedef short v4i16_t __attribute__((ext_vector_type(4)));
__device__ __forceinline__ void kload8(bf16x8*kf,lds_cptr kp){
  kf[0]=*(const __attribute__((address_space(3))) bf16x8*)(kp);      kf[1]=*(const __attribute__((address_space(3))) bf16x8*)(kp+512);
  kf[2]=*(const __attribute__((address_space(3))) bf16x8*)(kp+2048); kf[3]=*(const __attribute__((address_space(3))) bf16x8*)(kp+2560);
  kf[4]=*(const __attribute__((address_space(3))) bf16x8*)(kp+4096); kf[5]=*(const __attribute__((address_space(3))) bf16x8*)(kp+4608);
  kf[6]=*(const __attribute__((address_space(3))) bf16x8*)(kp+6144); kf[7]=*(const __attribute__((address_space(3))) bf16x8*)(kp+6656);
}
__device__ __forceinline__ void kload2(bf16x8*kf,lds_cptr kp,int j){ kf[2*j]=*(const __attribute__((address_space(3))) bf16x8*)(kp+j*2048); kf[2*j+1]=*(const __attribute__((address_space(3))) bf16x8*)(kp+j*2048+512); }
__device__ __forceinline__ s16x4 vtr(lds_cptr p){ return __builtin_bit_cast(s16x4,__builtin_amdgcn_ds_read_tr16_b64_v4i16((__attribute__((address_space(3))) v4i16_t*)p)); }
__device__ __forceinline__ float rowmax(const f32x16&p0,const f32x16&p1){
  float a=max3f(p0[0],p0[1],p1[0]),b=max3f(p0[2],p0[3],p1[1]);a=max3f(a,p1[2],p1[3]);
  #pragma unroll
  for(int r=4;r<16;r+=4){a=max3f(a,p0[r],p0[r+1]);b=max3f(b,p0[r+2],p0[r+3]);a=max3f(a,p1[r],p1[r+1]);b=max3f(b,p1[r+2],p1[r+3]);}
  const float m=max2f(a,b);
  auto rr=__builtin_amdgcn_permlane32_swap(__float_as_uint(m),__float_as_uint(m),false,false);
  return max2f(__uint_as_float(rr[0]),__uint_as_float(rr[1]));
}
__device__ __forceinline__ void pv(f32x16*o,int vb,bf16x8 pa0,bf16x8 pa1,bf16x8 pa2,bf16x8 pa3){
  #pragma unroll
  for(int d0=0;d0<2;++d0){s16x4 lo[4],hi[4];
    #pragma unroll
    for(int ks=0;ks<4;++ks){
      asm volatile("ds_read_b64_tr_b16 %0,%1 offset:%c2":"=&v"(lo[ks]):"v"(vb),"i"(d0*4096+ks*1024):"memory");
      asm volatile("ds_read_b64_tr_b16 %0,%1 offset:%c2":"=&v"(hi[ks]):"v"(vb),"i"(d0*4096+ks*1024+512):"memory");}
    asm volatile("s_waitcnt lgkmcnt(0)":::"memory");SBAR();
    #define PK(k) (bf16x8){lo[k][0],lo[k][1],lo[k][2],lo[k][3],hi[k][0],hi[k][1],hi[k][2],hi[k][3]}
    o[d0]=__builtin_amdgcn_mfma_f32_32x32x16_bf16(pa0,PK(0),o[d0],0,0,0);
    o[d0]=__builtin_amdgcn_mfma_f32_32x32x16_bf16(pa1,PK(1),o[d0],0,0,0);
    o[d0]=__builtin_amdgcn_mfma_f32_32x32x16_bf16(pa2,PK(2),o[d0],0,0,0);
    o[d0]=__builtin_amdgcn_mfma_f32_32x32x16_bf16(pa3,PK(3),o[d0],0,0,0);
    #undef PK
  }
}
template<int TYPE,int THRL> __device__ __forceinline__ void attn_unit(const Params&P,int layer,int b,int h,int qb,char*shm,bool pre=false,int nxt=-1){
  const int tid=tid_now(),lane=tid&63,r32=lane&31,hi=lane>>5; const int wid=__builtin_amdgcn_readfirstlane(tid>>6);
  const bool isctx=(qb==8);
  const int crow0=NLAT+b*CTXL, lrow0=b*SEQ;
  const int q0=isctx?crow0:lrow0+qb*QB;
  const int NT=isctx?4:36;
  const int qcol=TYPE==0?C_AQ+h*64:C_BQ+h*64, kcol=TYPE==0?C_AK+h*64:C_BK+(h>>1)*64, vcol=TYPE==0?C_AV+h*64:C_BV+(h>>1)*64;
  const bf16_t*Qw=((bf16_t*)(P.ws + WS_PROJ))+(size_t)(q0+wid*QBLK)*PITCH+qcol;
  const unsigned lds0=(unsigned)(uintptr_t)shm;
  float*wsf=(float*)(shm+LDS_WS)+wid*64;
  const bf16_t*ksrc=((bf16_t*)(P.ws + WS_PROJ))+(long)lane*PITCH+kcol+wid*8;
  const bf16_t*vsrc=((bf16_t*)(P.ws + WS_PROJ))+(long)(16*(wid&3)+(lane>>2))*PITCH+vcol+(wid>>2)*32+(lane&3)*8;
  const unsigned kdst=lds0+LDS_K+wid*1024, vdst=lds0+LDS_V+wid*1024;
  #define TROW(t) ((long)((t)<4?crow0+(t)*KVBLK:lrow0+((t)-4)*KVBLK)*PITCH)
  #define DMA_K(t,slot) glds16(ksrc+TROW(t),(unsigned)__builtin_amdgcn_readfirstlane(kdst+(slot)))
  #define DMA_V(t,slot) glds16(vsrc+TROW(t),(unsigned)__builtin_amdgcn_readfirstlane(vdst+(slot)))
  const int vb0=(int)(lds0+LDS_V)+((lane>>4)&1)*32+(lane&3)*8+(4*hi+((lane&15)>>2))*64;
  const char*Kbase=shm+LDS_K; bf16x8 kf[8];
  const lds_cptr shm3=(lds_cptr)shm; const lds_cptr kp0=shm3+LDS_K+hi*1024+r32*16; const lds_cptr vp0=shm3+LDS_V+((lane>>4)&1)*32+(lane&3)*8+(4*hi+((lane&15)>>2))*64;
  float*stgf=(float*)(shm+LDS_OST)+wid*2048;
  for(int pass=0;pass<(TYPE==0?2:1);++pass){
  if(!(pre&&pass==0)&&!(TYPE==0&&pass==1)){DMA_K(0,0);DMA_V(0,0);DMA_K(1,SLOTB);}
  bf16x8 qr[4];
  #pragma unroll
  for(int d0=0;d0<(TYPE==0?2:4);++d0)qr[d0]=*reinterpret_cast<const bf16x8*>(&Qw[(long)r32*PITCH+((TYPE==0?2*pass:0)+d0)*16+hi*8]);
  if(TYPE==0){qr[2]=qr[0];qr[3]=qr[1];}
  const int koff=TYPE==0?pass*4096:0; const lds_cptr kpp=kp0+koff;
  float mhat=0.f,l_reg=0.f;f32x16 o[2];o[0]=f32x16{};o[1]=f32x16{};f32x16 negm=f32x16{};asm volatile("":"+v"(negm));
  bool resc=false;
  #define START(P0,P1) do{ const float rm=rowmax(P0,P1); resc=false; \
    { const float dl=rm; mhat=fadd_s(mhat,dl); \
      _Pragma("unroll") for(int r=0;r<16;++r){P0[r]=fsub_s(P0[r],dl);P1[r]=fsub_s(P1[r],dl);} \
      _Pragma("unroll") for(int r=0;r<16;++r)negm[r]=-mhat; asm volatile("":"+v"(negm)); } \
    _Pragma("unroll") for(int r=0;r<16;++r)P0[r]=__builtin_amdgcn_exp2f(P0[r]); }while(0)
  #define RESC() do{ if(resc){ asm volatile("s_waitcnt lgkmcnt(0)":::"memory"); \
      _Pragma("unroll") for(int d_=0;d_<2;++d_) _Pragma("unroll") for(int r=0;r<16;++r)o[d_][r]*=wsf[crow(r,hi)]; } }while(0)
  f32x16 pA0,pA1,pB0,pB1;
  int sl_prev=0,sl_cur=0,sl_next=SLOTB;
  #define ROT() do{sl_prev=sl_cur;sl_cur=sl_next;sl_next=(sl_next==(NSLOT-1)*SLOTB)?0:sl_next+SLOTB;}while(0)
  DMA_K(2,2*SLOTB);
  WAIT_BAR(3);
  qkt<(TYPE==0?2:4)>(pA0,pA1,Kbase+koff,qr,negm,r32,hi);asm volatile("s_nop 15\n\ts_nop 7":"+v"(pA0),"+v"(pA1));
  START(pA0,pA1);
  _Pragma("unroll") for(int r=0;r<16;++r)pA1[r]=__builtin_amdgcn_exp2f(pA1[r]);
  WAIT_BAR(0);
  DMA_K(3,0);DMA_V(1,SLOTB);
  ROT();
  if(TYPE==0){kload2(kf,kpp+sl_cur,0);kload2(kf,kpp+sl_cur,1);}else kload8(kf,kp0+sl_cur);
  WAIT_BAR(2);
  s16x4 vlo[8],vhi[8]; u32x4 pw0,pw1,pw2,pw3;
  #define PKW(P,B) cvtpk_s(P[B],P[B+1])
  #define PAF(k) __builtin_bit_cast(bf16x8,pw##k)
  #define VFR(i) (bf16x8){vlo[i][0],vlo[i][1],vlo[i][2],vlo[i][3],vhi[i][0],vhi[i][1],vhi[i][2],vhi[i][3]}
  #define PIN(x) asm volatile("":"+v"(x))
  #define MX3(a,b,c) __builtin_fmaxf(__builtin_fmaxf((a),(b)),(c))
  #define GAPA(MF,A0,A1,A2,A3,W0,W1,PW) do{ MF; sacc+=A0; sacc+=A1; sacc+=A2; sacc+=A3; PIN(sacc); W0; W1; PIN(PW); SBAR(); }while(0)
  #define EX(v) __builtin_amdgcn_exp2f(v)
  #define GAPB(MF,X,B) do{ MF; X[B]=EX(X[B]); X[B+1]=EX(X[B+1]); X[B+2]=EX(X[B+2]); X[B+3]=EX(X[B+3]); PIN(X); SBAR(); }while(0)
  #define VRD(i) do{ vlo[i]=vtr(vp_+(((i)>>2)*4096+((i)&3)*1024)); vhi[i]=vtr(vp_+(((i)>>2)*4096+((i)&3)*1024+512)); }while(0)
  #define KRD(G,j) do{ if((G)&&(TYPE!=0||(j)<2)){ kload2(kf,kpp+sl_next,j); SBAR(); } }while(0)
  #define STEP(C0,C1,P0,P1,t,GK,GV,GL) do{ SBAR(); \
    const lds_cptr vp_=vp0+sl_prev; \
    VRD(0); SBAR(); float sacc=(P0[0]+P0[1]); \
    GAPA(C0=__builtin_amdgcn_mfma_f32_32x32x16_bf16(kf[0],qr[0],negm,0,0,0), P0[2],P0[3],P0[4],P0[5],     pw0[0]=PKW(P0,0), pw0[1]=PKW(P0,2), pw0); \
    VRD(4); SBAR(); GAPA(C1=__builtin_amdgcn_mfma_f32_32x32x16_bf16(kf[1],qr[0],negm,0,0,0), P0[6],P0[7],P0[8],P0[9],     pw0[2]=PKW(P0,4), pw0[3]=PKW(P0,6), pw0); \
    VRD(1); SBAR(); GAPA(C0=__builtin_amdgcn_mfma_f32_32x32x16_bf16(kf[2],qr[1],C0,0,0,0),   P0[10],P0[11],P0[12],P0[13], pw1[0]=PKW(P0,8), pw1[1]=PKW(P0,10), pw1); \
    VRD(5); SBAR(); GAPA(C1=__builtin_amdgcn_mfma_f32_32x32x16_bf16(kf[3],qr[1],C1,0,0,0),   P0[14],P0[15],P1[0],P1[1],   pw1[2]=PKW(P0,12),pw1[3]=PKW(P0,14), pw1); \
    VRD(2); SBAR(); GAPA(if(TYPE!=0)C0=__builtin_amdgcn_mfma_f32_32x32x16_bf16(kf[4],qr[2],C0,0,0,0),   P1[2],P1[3],P1[4],P1[5],     pw2[0]=PKW(P1,0), pw2[1]=PKW(P1,2), pw2); \
    VRD(6); SBAR(); GAPA(if(TYPE!=0)C1=__builtin_amdgcn_mfma_f32_32x32x16_bf16(kf[5],qr[2],C1,0,0,0),   P1[6],P1[7],P1[8],P1[9],     pw2[2]=PKW(P1,4), pw2[3]=PKW(P1,6), pw2); \
    VRD(3); SBAR(); GAPA(if(TYPE!=0)C0=__builtin_amdgcn_mfma_f32_32x32x16_bf16(kf[6],qr[3],C0,0,0,0),   P1[10],P1[11],P1[12],P1[13], pw3[0]=PKW(P1,8), pw3[1]=PKW(P1,10), pw3); \
    VRD(7); SBAR(); GAPA(if(TYPE!=0)C1=__builtin_amdgcn_mfma_f32_32x32x16_bf16(kf[7],qr[3],C1,0,0,0),   P1[14],P1[15],0.f,0.f,       pw3[2]=PKW(P1,12),pw3[3]=PKW(P1,14), pw3); \
    l_reg+=sacc; \
    if(GK){DMA_K((t)+3,sl_cur);} if(GV){DMA_V((t)+1,sl_next);} \
    { float a=MX3(C0[0],C0[1],C1[0]),b=MX3(C0[2],C0[3],C1[1]); a=MX3(a,C1[2],C1[3]); \
      _Pragma("unroll") for(int r=4;r<16;r+=4){a=MX3(a,C0[r],C0[r+1]);b=MX3(b,C0[r+2],C0[r+3]);a=MX3(a,C1[r],C1[r+1]);b=MX3(b,C1[r+2],C1[r+3]);} \
      float rm=__builtin_fmaxf(a,b); { auto rr=__builtin_amdgcn_permlane32_swap(__float_as_uint(rm),__float_as_uint(rm),false,false); rm=__builtin_fmaxf(__uint_as_float(rr[0]),__uint_as_float(rr[1])); } \
      resc=false; \
      if(__builtin_expect(__any(rm>(float)THRL),0)){ const float dl=__builtin_fmaxf(rm,0.f); mhat+=dl; \
        _Pragma("unroll") for(int r=0;r<16;++r){C0[r]-=dl;C1[r]-=dl;} \
        _Pragma("unroll") for(int r=0;r<16;++r)negm[r]=-mhat; asm volatile("":"+v"(negm)); \
        const float f=__builtin_amdgcn_exp2f(-dl); l_reg*=f; if(hi==0)wsf[r32]=f; resc=true; } } \
    SBAR(); \
    GAPB(o[0]=__builtin_amdgcn_mfma_f32_32x32x16_bf16(PAF(0),VFR(0),o[0],0,0,0), C0,0); \
    GAPB(o[1]=__builtin_amdgcn_mfma_f32_32x32x16_bf16(PAF(0),VFR(4),o[1],0,0,0), C0,4); \
    KRD(GL,0); GAPB(o[0]=__builtin_amdgcn_mfma_f32_32x32x16_bf16(PAF(1),VFR(1),o[0],0,0,0), C0,8); \
    KRD(GL,1); GAPB(o[1]=__builtin_amdgcn_mfma_f32_32x32x16_bf16(PAF(1),VFR(5),o[1],0,0,0), C0,12); \
    KRD(GL,2); GAPB(o[0]=__builtin_amdgcn_mfma_f32_32x32x16_bf16(PAF(2),VFR(2),o[0],0,0,0), C1,0); \
    KRD(GL,3); GAPB(o[1]=__builtin_amdgcn_mfma_f32_32x32x16_bf16(PAF(2),VFR(6),o[1],0,0,0), C1,4); \
    GAPB(o[0]=__builtin_amdgcn_mfma_f32_32x32x16_bf16(PAF(3),VFR(3),o[0],0,0,0), C1,8); \
    GAPB(o[1]=__builtin_amdgcn_mfma_f32_32x32x16_bf16(PAF(3),VFR(7),o[1],0,0,0), C1,12); \
    }while(0)
  int t=1;
  for(;t+5<NT;t+=2){
    STEP(pB0,pB1,pA0,pA1,t,true,true,true);     WAIT_BAR(2); RESC(); ROT();
    STEP(pA0,pA1,pB0,pB1,t+1,true,true,true);   WAIT_BAR(2); RESC(); ROT();
  }
  #define ENDW(tt) do{ if((tt)+3<NT){WAIT_BAR(2);} else if((tt)+2<NT){WAIT_BAR(1);} else {WAIT_BAR(0);} }while(0)
  for(;t+1<NT;t+=2){
    STEP(pB0,pB1,pA0,pA1,t,(t+3<NT),(t+1<NT),(t+1<NT));       ENDW(t);   RESC(); ROT();
    STEP(pA0,pA1,pB0,pB1,t+1,(t+4<NT),(t+2<NT),(t+2<NT));     ENDW(t+1); RESC(); ROT();
  }
  STEP(pB0,pB1,pA0,pA1,NT-1,false,false,false); RESC();
  { float sacc=pB0[0]+pB0[1]; _Pragma("unroll") for(int r=2;r<16;++r)sacc+=pB0[r]; _Pragma("unroll") for(int r=0;r<16;++r)sacc+=pB1[r]; l_reg+=sacc;
    pw0=(u32x4){PKW(pB0,0),PKW(pB0,2),PKW(pB0,4),PKW(pB0,6)};pw1=(u32x4){PKW(pB0,8),PKW(pB0,10),PKW(pB0,12),PKW(pB0,14)};pw2=(u32x4){PKW(pB1,0),PKW(pB1,2),PKW(pB1,4),PKW(pB1,6)};pw3=(u32x4){PKW(pB1,8),PKW(pB1,10),PKW(pB1,12),PKW(pB1,14)};
    SBAR(); pv(o,vb0+sl_cur,PAF(0),PAF(1),PAF(2),PAF(3)); }
  #undef PKW
  #undef PAF
  #undef VFR
  #undef PIN
  #undef MX3
  #undef GAPA
  #undef GAPB
  #undef EX
  #undef VRD
  #undef KRD
  #undef STEP
  #undef ENDW
  asm volatile("s_waitcnt lgkmcnt(0)\n\ts_barrier":::"memory");
  if(TYPE==0&&pass==0){DMA_K(0,0);DMA_V(0,0);DMA_K(1,SLOTB);}
  else if(nxt>=0){ const int nt_=nxt>>12,nb_=(nxt>>4)&15,nh_=nxt&3; const int nk_=nt_==0?C_AK+nh_*64:C_BK+(nh_>>1)*64, nv_=nt_==0?C_AV+nh_*64:C_BV+(nh_>>1)*64;
    const bf16_t*nks=((bf16_t*)(P.ws + WS_PROJ))+(long)lane*PITCH+nk_+wid*8+(long)(NLAT+nb_*CTXL)*PITCH;
    const bf16_t*nvs=((bf16_t*)(P.ws + WS_PROJ))+(long)(16*(wid&3)+(lane>>2))*PITCH+nv_+(wid>>2)*32+(lane&3)*8+(long)(NLAT+nb_*CTXL)*PITCH;
    glds16(nks,(unsigned)__builtin_amdgcn_readfirstlane(kdst)); glds16(nvs,(unsigned)__builtin_amdgcn_readfirstlane(vdst)); glds16(nks+(long)KVBLK*PITCH,(unsigned)__builtin_amdgcn_readfirstlane(kdst+SLOTB)); }
  {auto rr=__builtin_amdgcn_permlane32_swap(__float_as_uint(l_reg),__float_as_uint(l_reg),false,false);l_reg=__uint_as_float(rr[0])+__uint_as_float(rr[1]);}
  if(hi==0)wsf[32+r32]=l_reg;asm volatile("s_waitcnt lgkmcnt(0)":::"memory");
  float rli[16];
  #pragma unroll
  for(int r=0;r<16;++r)rli[r]=__builtin_amdgcn_rcpf(wsf[32+crow(r,hi)]);
  if(TYPE==0&&pass==0){
    #pragma unroll
    for(int d0=0;d0<2;++d0)
      #pragma unroll
      for(int r=0;r<16;++r)stgf[(d0*16+r)*64+lane]=o[d0][r]*rli[r];
    continue;
  }
  if(TYPE==0){ const float lam=((float*)(P.ws + WS_TAB))[T_LAM+layer];
    #pragma unroll
    for(int d0=0;d0<2;++d0)
      #pragma unroll
      for(int r=0;r<16;++r)o[d0][r]=stgf[(d0*16+r)*64+lane]-lam*(o[d0][r]*rli[r]);
    asm volatile("s_waitcnt lgkmcnt(0)":::"memory");
  } else {
    #pragma unroll
    for(int d0=0;d0<2;++d0)
      #pragma unroll
      for(int r=0;r<16;++r)o[d0][r]*=rli[r];
  }
  asm volatile("":"+v"(o[0]),"+v"(o[1])::"memory");
  #pragma unroll
  for(int r=0;r<16;++r){const int orow=crow(r,hi);
    #pragma unroll
    for(int d0=0;d0<2;++d0)stgf[orow*64+d0*32+r32]=o[d0][r];}
  asm volatile("s_waitcnt lgkmcnt(0)":::"memory");
  { const float post=TYPE==0?(1.f-((float*)(P.ws + WS_TAB))[T_LAMI+layer]):1.f; const float*sg=PVEC(P)+PV_SUBLN+layer*64;
    #pragma unroll
    for(int ih=0;ih<2;++ih){
    u32x4 zws[2];
    #pragma unroll
    for(int i=0;i<2;++i){const size_t grow=(size_t)(q0+wid*QBLK+(2*ih+i)*8+(lane>>3)); zws[i]=*(const u32x4*)(((bf16_t*)(P.ws + WS_PROJ))+grow*PITCH+(TYPE==0?C_AZ:C_BZ)+h*64+(lane&7)*8);}
    #pragma unroll
    for(int i2=0;i2<2;++i2){const int i=2*ih+i2; const int row=i*8+(lane>>3),ch=lane&7; const f32x4 v0=*(const f32x4*)(stgf+row*64+ch*8), v1=*(const f32x4*)(stgf+row*64+ch*8+4);
      const size_t grow=(size_t)(q0+wid*QBLK+row);
      const u32x4 zw=zws[i2];
      f32x4 a=v0,c=v1;
      if(TYPE==0){ float ss=(v0.x*v0.x+v0.y*v0.y)+(v0.z*v0.z+v0.w*v0.w)+(v1.x*v1.x+v1.y*v1.y)+(v1.z*v1.z+v1.w*v1.w);
        ss+=__shfl_xor(ss,1);ss+=__shfl_xor(ss,2);ss+=__shfl_xor(ss,4);
        const float rs=rsqrtf(ss*(1.f/64.f)+EPS)*post; a=a*rs*(*(const f32x4*)(sg+ch*8)); c=c*rs*(*(const f32x4*)(sg+ch*8+4)); }
      const u32x4 w={pk2(a.x*bflo(zw.x),a.y*bfhi(zw.x)),pk2(a.z*bflo(zw.y),a.w*bfhi(zw.y)),pk2(c.x*bflo(zw.z),c.y*bfhi(zw.z)),pk2(c.z*bflo(zw.w),c.w*bfhi(zw.w))};
      *(u32x4*)(((bf16_t*)(P.ws + WS_Y))+grow*DM+(TYPE==0?0:256)+h*64+ch*8)=w; } } }
  }
  #undef DMA_K
  #undef DMA_V
  #undef TROW
  #undef START
  #undef RESC
  #undef ROT
}
#undef SBAR
#undef WAIT_BAR
}
__device__ __forceinline__ bf16_t* of_row(const Params& P, int dir, int row) {
  const bool lat = row < NLAT; const int c = row - NLAT; const int x = lat ? (row >> 12) : (c >> 9), lr = lat ? (row & 4095) : 4096 + (c & 511);
  return ((bf16_t*)(P.ws + WS_XS)) + (size_t)x * (4096 * 1024) + ((size_t)dir * 4608 + lr) * 256;
}
namespace gla {
typedef short bf16x8 __attribute__((ext_vector_type(8)));
typedef float f32x16 __attribute__((ext_vector_type(16)));
__device__ __forceinline__ int crow(int r, int hi) { return (r & 3) + 8 * (r >> 2) + 4 * hi; }
constexpr int GRP_BYTES = 62464;
__device__ __forceinline__ size_t gblk(int chunk, int h, int dir) { return ((size_t)(chunk * 4 + h) * 2 + dir) * 2048; }
__device__ __forceinline__ int chunk_row0(int b, int cidx) { return cidx < 4 ? NLAT + b * CTXL + 64 * cidx : b * SEQ + 64 * (cidx - 4); }
__device__ __forceinline__ int p2_cidx(int dir, int step) { return dir == 0 ? step : (step < 4 ? 3 - step : 39 - step); }
struct P1In { float g[8]; u32x4 qw, kw, v0, v1; };
__device__ __forceinline__ P1In part1_load(const Params& P, int b, int h, int cidx) {
  const int tid = tid_now(), dir = tid >> 8, t4 = tid & 255; const int row0 = chunk_row0(b, cidx);
  P1In in; const int d = t4 & 31, seg = t4 >> 5;
#pragma unroll
  for (int e = 0; e < 8; ++e) { const int ip = 8 * seg + e; const int row = row0 + (dir ? 63 - ip : ip); in.g[e] = ((float*)(P.ws + WS_GATE))[gblk(row0 >> 6, h, dir) + (size_t)(row - row0) * 32 + d]; }
  const int prow = row0 + (dir ? 63 - (t4 >> 2) : (t4 >> 2));
  const bf16_t* pr_ = ((bf16_t*)(P.ws + WS_PROJ)) + (size_t)prow * NPROJ;
  in.qw = *(const u32x4*)(pr_ + C_DQ + h * 32 + 8 * (t4 & 3)); in.kw = *(const u32x4*)(pr_ + C_DK + h * 32 + 8 * (t4 & 3));
  in.v0 = *(const u32x4*)(pr_ + C_DV + h * 64 + 16 * (t4 & 3)); in.v1 = *(const u32x4*)(pr_ + C_DV + h * 64 + 16 * (t4 & 3) + 8);
  return in;
}
__device__ __forceinline__ void unit(const Params& P, int layer, int b, int h, unsigned char* lds) {
  const int tid = tid_now(), dir = tid >> 8, t4 = tid & 255, w4 = (tid >> 6) & 3, lane = tid & 63, r32 = lane & 31, hi = lane >> 5;
  unsigned char* base = lds + dir * GRP_BYTES;
  float* Gs = (float*)base;
  float* SEG = Gs + 64 * 33;
  float* GL = SEG + 256;
  bf16_t* QEs = (bf16_t*)(base + 9600);
  bf16_t* KDs = QEs + 64 * 40;
  bf16_t* KEt = KDs + 64 * 40;
  bf16_t* Vt = KEt + 32 * 72;
  bf16_t* As = Vt + 64 * 72;
  bf16_t* St = (bf16_t*)(base + 43008);
  bf16_t* Os = (bf16_t*)(base + 53248);
  f32x16 Sreg = {0.f, 0.f, 0.f, 0.f, 0.f, 0.f, 0.f, 0.f, 0.f, 0.f, 0.f, 0.f, 0.f, 0.f, 0.f, 0.f};
  __syncthreads();
#pragma unroll
  for (int i = 0; i < 5; ++i) ((unsigned*)St)[t4 + 256 * i] = 0u;
  P1In cur = part1_load(P, b, h, p2_cidx(dir, 0));
  for (int s = 0; s < 36; ++s) {
    const int cidx = p2_cidx(dir, s); const int row0 = chunk_row0(b, cidx);
    const P1In in = cur; cur = part1_load(P, b, h, p2_cidx(dir, s < 35 ? s + 1 : 35));
    const u32x4 qw = in.qw, kw = in.kw, v0 = in.v0, v1 = in.v1;
    __syncthreads();
    if (s > 0) { const int tok = t4 >> 2, sg = t4 & 3; const int rowp = chunk_row0(b, p2_cidx(dir, s - 1)) + tok;
      bf16_t* op = of_row(P, dir, rowp) + h * 64 + sg * 16;
      const u32x4 o0 = *(const u32x4*)(Os + tok * 72 + sg * 16), o1 = *(const u32x4*)(Os + tok * 72 + sg * 16 + 8); *(u32x4*)op = o0; *(u32x4*)(op + 8) = o1; }
    { const int d = t4 & 31, seg = t4 >> 5;
      float p[8]; float run = 0.f;
#pragma unroll
      for (int e = 0; e < 8; ++e) { run += in.g[e]; p[e] = run; }
      SEG[seg * 32 + d] = run;
      __syncthreads();
      float off = 0.f;
#pragma unroll
      for (int s2 = 0; s2 < 8; ++s2) { const float sv = SEG[s2 * 32 + d]; off += (s2 < seg) ? sv : 0.f; }
#pragma unroll
      for (int e = 0; e < 8; ++e) Gs[(8 * seg + e) * 33 + d] = p[e] + off;
      if (seg == 7) GL[d] = p[7] + off;
    }
    __syncthreads();
    { const int ip = t4 >> 2, o8 = t4 & 3;
      const float q[8] = {bflo(qw.x), bfhi(qw.x), bflo(qw.y), bfhi(qw.y), bflo(qw.z), bfhi(qw.z), bflo(qw.w), bfhi(qw.w)};
      const float k[8] = {bflo(kw.x), bfhi(kw.x), bflo(kw.y), bfhi(kw.y), bflo(kw.z), bfhi(kw.z), bflo(kw.w), bfhi(kw.w)};
      float qe[8], kd[8], ke[8];
#pragma unroll
      for (int e = 0; e < 8; ++e) { const float G = Gs[ip * 33 + 8 * o8 + e], gl = GL[8 * o8 + e]; qe[e] = q[e] * __expf(G); kd[e] = k[e] * __expf(-G); ke[e] = k[e] * __expf(gl - G); }
      *(u32x4*)(QEs + ip * 40 + 8 * o8) = (u32x4){pk2(qe[0], qe[1]), pk2(qe[2], qe[3]), pk2(qe[4], qe[5]), pk2(qe[6], qe[7])};
      *(u32x4*)(KDs + ip * 40 + 8 * o8) = (u32x4){pk2(kd[0], kd[1]), pk2(kd[2], kd[3]), pk2(kd[4], kd[5]), pk2(kd[6], kd[7])};
#pragma unroll
      for (int e = 0; e < 8; ++e) KEt[(8 * o8 + e) * 72 + ip] = (bf16_t)f2bf(ke[e]);
      const unsigned vw[8] = {v0.x, v0.y, v0.z, v0.w, v1.x, v1.y, v1.z, v1.w};
#pragma unroll
      for (int e = 0; e < 8; ++e) { Vt[(16 * o8 + 2 * e) * 72 + ip] = (bf16_t)(vw[e] & 0xffffu); Vt[(16 * o8 + 2 * e + 1) * 72 + ip] = (bf16_t)(vw[e] >> 16); }
    }
    __syncthreads();
    { const int it = w4 >> 1, jt = w4 & 1;
      f32x16 acc = {0.f, 0.f, 0.f, 0.f, 0.f, 0.f, 0.f, 0.f, 0.f, 0.f, 0.f, 0.f, 0.f, 0.f, 0.f, 0.f};
      if (!(it == 0 && jt == 1)) {
#pragma unroll
        for (int s2 = 0; s2 < 2; ++s2) { const bf16x8 a = *(const bf16x8*)(QEs + (32 * it + r32) * 40 + 16 * s2 + 8 * hi); const bf16x8 bb = *(const bf16x8*)(KDs + (32 * jt + r32) * 40 + 16 * s2 + 8 * hi);
          acc = __builtin_amdgcn_mfma_f32_32x32x16_bf16(a, bb, acc, 0, 0, 0); } }
#pragma unroll
      for (int r = 0; r < 16; ++r) { const int ip = 32 * it + crow(r, hi), jp = 32 * jt + r32; As[ip * 72 + jp] = (bf16_t)f2bf(jp <= ip ? acc[r] : 0.f); }
    }
    __syncthreads();
    { const int it = w4 >> 1, nt = w4 & 1;
      const bf16_t* Sc = St + (s & 1) * 2560; bf16_t* Sn = St + ((s + 1) & 1) * 2560;
      f32x16 acc = {0.f, 0.f, 0.f, 0.f, 0.f, 0.f, 0.f, 0.f, 0.f, 0.f, 0.f, 0.f, 0.f, 0.f, 0.f, 0.f};
#pragma unroll
      for (int s2 = 0; s2 < 4; ++s2) { const bf16x8 a = *(const bf16x8*)(As + (32 * it + r32) * 72 + 16 * s2 + 8 * hi); const bf16x8 bb = *(const bf16x8*)(Vt + (32 * nt + r32) * 72 + 16 * s2 + 8 * hi);
        acc = __builtin_amdgcn_mfma_f32_32x32x16_bf16(a, bb, acc, 0, 0, 0); }
#pragma unroll
      for (int s2 = 0; s2 < 2; ++s2) { const bf16x8 a = *(const bf16x8*)(QEs + (32 * it + r32) * 40 + 16 * s2 + 8 * hi); const bf16x8 bb = *(const bf16x8*)(Sc + (32 * nt + r32) * 40 + 16 * s2 + 8 * hi);
        acc = __builtin_amdgcn_mfma_f32_32x32x16_bf16(a, bb, acc, 0, 0, 0); }
#pragma unroll
      for (int r = 0; r < 16; ++r) { const int ip = 32 * it + crow(r, hi); Os[(dir ? 63 - ip : ip) * 72 + 32 * nt + r32] = (bf16_t)f2bf(acc[r]); }
      if (w4 < 2) {
        f32x16 au = {0.f, 0.f, 0.f, 0.f, 0.f, 0.f, 0.f, 0.f, 0.f, 0.f, 0.f, 0.f, 0.f, 0.f, 0.f, 0.f};
#pragma unroll
        for (int s2 = 0; s2 < 4; ++s2) { const bf16x8 a = *(const bf16x8*)(KEt + r32 * 72 + 16 * s2 + 8 * hi); const bf16x8 bb = *(const bf16x8*)(Vt + (32 * w4 + r32) * 72 + 16 * s2 + 8 * hi);
          au = __builtin_amdgcn_mfma_f32_32x32x16_bf16(a, bb, au, 0, 0, 0); }
#pragma unroll
        for (int r = 0; r < 16; ++r) Sreg[r] = __expf(GL[crow(r, hi)]) * Sreg[r] + au[r];
#pragma unroll
        for (int q = 0; q < 4; ++q) *(u32x2*)(Sn + (32 * w4 + r32) * 40 + 8 * q + 4 * hi) = (u32x2){pk2(Sreg[4 * q], Sreg[4 * q + 1]), pk2(Sreg[4 * q + 2], Sreg[4 * q + 3])};
      }
    }
  }
  __syncthreads();
  { const int tok = t4 >> 2, sg = t4 & 3; const int rowp = chunk_row0(b, p2_cidx(dir, 35)) + tok;
    bf16_t* op = of_row(P, dir, rowp) + h * 64 + sg * 16;
    const u32x4 o0 = *(const u32x4*)(Os + tok * 72 + sg * 16), o1 = *(const u32x4*)(Os + tok * 72 + sg * 16 + 8); *(u32x4*)op = o0; *(u32x4*)(op + 8) = o1; }
  asm volatile("s_waitcnt vmcnt(0)" ::: "memory");
  __syncthreads();
  { const int wave = tid >> 6; const bool last = layer == DEPTH - 1;
    const int v4 = (lane & 15) * 4; const f32x4 g4 = *(const f32x4*)(PVEC(P) + PV_GLAG + layer * 64 + v4);
    for (int grp = 0; grp < 8; ++grp) {
      u32x2 a[9], bq[9], zw[9];
#pragma unroll
      for (int k = 0; k < 9; ++k) { const int itx = wave + 8 * (9 * grp + k); const int r = itx * 4 + (lane >> 4), cidx = r >> 6, ri = r & 63; const size_t row = (size_t)chunk_row0(b, cidx) + ri;
        a[k] = *(const u32x2*)(of_row(P, 0, (int)row) + h * 64 + v4); bq[k] = *(const u32x2*)(of_row(P, 1, (int)row) + h * 64 + v4);
        zw[k] = *(const u32x2*)(((bf16_t*)(P.ws + WS_PROJ)) + row * NPROJ + C_DZ + h * 64 + v4); }
#pragma unroll
      for (int k = 0; k < 9; ++k) { const int itx = wave + 8 * (9 * grp + k); const int r = itx * 4 + (lane >> 4), cidx = r >> 6, ri = r & 63; const size_t row = (size_t)chunk_row0(b, cidx) + ri;
        const f32x4 o = {bflo(a[k].x) + bflo(bq[k].x), bfhi(a[k].x) + bfhi(bq[k].x), bflo(a[k].y) + bflo(bq[k].y), bfhi(a[k].y) + bfhi(bq[k].y)};
        float ss = (o.x * o.x + o.y * o.y) + (o.z * o.z + o.w * o.w);
        ss += __shfl_xor(ss, 1); ss += __shfl_xor(ss, 2); ss += __shfl_xor(ss, 4); ss += __shfl_xor(ss, 8);
        const float rs = rsqrtf(ss * (1.f / 64.f) + EPS);
        if (!(last && cidx < 4)) *(u32x2*)(((bf16_t*)(P.ws + WS_Y)) + row * DM + 768 + h * 64 + v4) = (u32x2){pk2(o.x * rs * g4.x * bflo(zw[k].x), o.y * rs * g4.y * bfhi(zw[k].x)), pk2(o.z * rs * g4.z * bflo(zw[k].y), o.w * rs * g4.w * bfhi(zw[k].y))}; }
    }
  }
  __syncthreads();
}
}
struct SguIn { u32x4 w[8]; };
__device__ __forceinline__ SguIn sgu_load(const Params& P, int ch) {
  const int tid = tid_now(); const int pos = tid >> 2, q4 = tid & 3; const bf16_t* src = ((bf16_t*)(P.ws + WS_PROJ)) + (size_t)(ch * 128 + pos) * NPROJ + C_CV + q4 * 64;
  SguIn in;
#pragma unroll
  for (int c = 0; c < 8; ++c) in.w[c] = *(const u32x4*)(src + 8 * c);
  return in;
}
__device__ __forceinline__ void sgu_unit(const Params& P, int layer, int ch, const SguIn& sin, unsigned char* lds) {
  typedef short bf16x8 __attribute__((ext_vector_type(8)));
  typedef float f32x16 __attribute__((ext_vector_type(16)));
  bf16_t* vnT = (bf16_t*)lds;
  const int tid = tid_now(), wave = tid >> 6, lane = tid & 63, r32 = lane & 31, hi = lane >> 5; const int row0 = ch * 128;
  const int g = wave >> 1, ct = wave & 1;
  bf16_t* Ub = (bf16_t*)(lds + 69632 + wave * 5120); bf16_t* Zb = Ub + 1280;
  float* sgb = (float*)(lds + 110592);
  float* lgs = (float*)(lds + 112640);
  const bf16_t* W = (const bf16_t*)(P.ws + WS_SGW) + (size_t)(layer * 4 + g) * 128 * 128;
  const int cb = g * 64 + 32 * ct, lrow = lane >> 1, lhalf = lane & 1;
  const bf16_t* pj = ((bf16_t*)(P.ws + WS_PROJ)) + (size_t)(row0 + lrow) * NPROJ + cb + lhalf * 16;
  bf16_t* yo = ((bf16_t*)(P.ws + WS_Y)) + (size_t)(row0 + lrow) * DM + 512 + cb + lhalf * 16;
  const float sv = PVEC(P)[PV_SGB + layer * 512 + tid], lv = tid < 256 ? PVEC(P)[PV_LNG + layer * 256 + tid] : PVEC(P)[PV_LNB + layer * 256 + tid - 256];
  bf16x8 wA[8], wB[8]; u32x4 uz[4][4];
#define SGU_LOAD(w_, it_) do { _Pragma("unroll") for (int s = 0; s < 8; ++s) w_[s] = *(const bf16x8*)(W + (size_t)(32 * (it_) + r32) * 128 + 16 * s + 8 * hi); } while (0)
#define SGU_PUT(it_) do { *(u32x4*)(Ub + lrow * 40 + lhalf * 16) = uz[it_][0]; *(u32x4*)(Ub + lrow * 40 + lhalf * 16 + 8) = uz[it_][1]; *(u32x4*)(Zb + lrow * 40 + lhalf * 16) = uz[it_][2]; *(u32x4*)(Zb + lrow * 40 + lhalf * 16 + 8) = uz[it_][3]; } while (0)
#define SGU_TILE(w_, it_) do { f32x16 acc = {0.f, 0.f, 0.f, 0.f, 0.f, 0.f, 0.f, 0.f, 0.f, 0.f, 0.f, 0.f, 0.f, 0.f, 0.f, 0.f}; \
      _Pragma("unroll") for (int s = 0; s < 8; ++s) acc = __builtin_amdgcn_mfma_f32_32x32x16_bf16(w_[s], bfr[s], acc, 0, 0, 0); \
      float ov[16]; \
      _Pragma("unroll") for (int r = 0; r < 16; ++r) { const int il = (r & 3) + 8 * (r >> 2) + 4 * hi; ov[r] = bf2f(Ub[il * 40 + r32]) * (acc[r] + sgb[g * 128 + 32 * (it_) + il]) * bf2f(Zb[il * 40 + r32]); } \
      _Pragma("unroll") for (int r = 0; r < 16; ++r) { const int il = (r & 3) + 8 * (r >> 2) + 4 * hi; Ub[il * 40 + r32] = (bf16_t)f2bf(ov[r]); } \
      const u32x4 o0 = *(const u32x4*)(Ub + lrow * 40 + lhalf * 16), o1 = *(const u32x4*)(Ub + lrow * 40 + lhalf * 16 + 8); \
      bf16_t* y_ = yo + (size_t)(32 * (it_)) * DM; *(u32x4*)y_ = o0; *(u32x4*)(y_ + 8) = o1; } while (0)
  SGU_LOAD(wA, 0);
#pragma unroll
  for (int it = 0; it < 4; ++it) { const bf16_t* p_ = pj + (size_t)(32 * it) * NPROJ; uz[it][0] = *(const u32x4*)(p_ + C_CU); uz[it][1] = *(const u32x4*)(p_ + C_CU + 8); uz[it][2] = *(const u32x4*)(p_ + C_CZ); uz[it][3] = *(const u32x4*)(p_ + C_CZ + 8); }
  sgb[tid] = sv; lgs[tid] = lv;
  __syncthreads();
  { const int pos = tid >> 2, q4 = tid & 3;
    float x[64];
#pragma unroll
    for (int c = 0; c < 8; ++c) { const u32x4 w = sin.w[c]; x[8 * c] = bflo(w.x); x[8 * c + 1] = bfhi(w.x); x[8 * c + 2] = bflo(w.y); x[8 * c + 3] = bfhi(w.y); x[8 * c + 4] = bflo(w.z); x[8 * c + 5] = bfhi(w.z); x[8 * c + 6] = bflo(w.w); x[8 * c + 7] = bfhi(w.w); }
    float s = 0.f;
#pragma unroll
    for (int c = 0; c < 64; ++c) s += x[c];
    s += __shfl_xor(s, 1); s += __shfl_xor(s, 2);
    const float mu = s * (1.f / 256.f); float s2 = 0.f;
#pragma unroll
    for (int c = 0; c < 64; ++c) { const float d = x[c] - mu; s2 += d * d; }
    s2 += __shfl_xor(s2, 1); s2 += __shfl_xor(s2, 2);
    const float rstd = rsqrtf(s2 * (1.f / 256.f) + EPS);
    const float* lg = lgs + q4 * 64; const float* lb = lgs + 256 + q4 * 64;
#pragma unroll
    for (int c = 0; c < 64; ++c) vnT[(q4 * 64 + c) * 136 + pos] = (bf16_t)f2bf((x[c] - mu) * rstd * lg[c] + lb[c]); }
  __syncthreads();
  { bf16x8 bfr[8];
#pragma unroll
    for (int s = 0; s < 8; ++s) bfr[s] = *(const bf16x8*)(vnT + (g * 64 + 32 * ct + r32) * 136 + 16 * s + 8 * hi);
    SGU_PUT(0);
    SGU_LOAD(wB, 1); SGU_TILE(wA, 0); SGU_PUT(1);
    SGU_LOAD(wA, 2); SGU_TILE(wB, 1); SGU_PUT(2);
    SGU_LOAD(wB, 3); SGU_TILE(wA, 2); SGU_PUT(3);
    SGU_TILE(wB, 3);
#undef SGU_LOAD
#undef SGU_PUT
#undef SGU_TILE
  }
  __syncthreads();
}
constexpr int XQ_CA0 = 0, XQ_CB0 = 8, XQ_CS0 = 16, XQ_A0 = 20, XQ_B0 = 84, XQ_S0 = 148, XQ_N = 180;
__device__ __forceinline__ unsigned grp_l2_add(unsigned* p, unsigned v) { unsigned r; asm volatile("global_atomic_add %0, %1, %2, off sc0\n\ts_waitcnt vmcnt(0)" : "=&v"(r) : "v"(p), "v"(v) : "memory"); return r; }
__device__ __forceinline__ void grp_signal(unsigned* cnt, bool local) {
  asm volatile("s_waitcnt vmcnt(0)" ::: "memory");
  __syncthreads();
  if (threadIdx.x == 0) {
    if (local) (void)grp_l2_add(cnt, 1u);
    else { __builtin_amdgcn_fence(__ATOMIC_RELEASE, "agent"); asm volatile("s_waitcnt vmcnt(0)" ::: "memory"); (void)__hip_atomic_fetch_add(cnt, 1u, __ATOMIC_RELAXED, __HIP_MEMORY_SCOPE_AGENT); } }
}
__device__ __forceinline__ void grp_wait(unsigned* cnt, unsigned target, bool local) {
  if (threadIdx.x == 0) { unsigned sp = 0u;
    if (local) { while (grp_l2_add(cnt, 0u) < target) { __builtin_amdgcn_s_sleep(2); if (++sp > (1u << 20)) break; } }
    else { while (__hip_atomic_load(cnt, __ATOMIC_RELAXED, __HIP_MEMORY_SCOPE_AGENT) < target) { __builtin_amdgcn_s_sleep(2); if (++sp > (1u << 22)) break; } }
    __builtin_amdgcn_fence(__ATOMIC_ACQUIRE, "agent");
    asm volatile("s_waitcnt vmcnt(0)" ::: "memory"); }
  __syncthreads();
}
struct OneTile { int pm, pn;
  __device__ __forceinline__ bool next(int i, pg8::Unit& u) const { if (i != 0) return false; u.pm = pm; u.pn = pn; return true; }
  __device__ __forceinline__ void a_ready(const pg8::Unit&) const {}
  __device__ __forceinline__ void done(const pg8::Unit&) const {} };
__device__ __forceinline__ int xq_pull(unsigned* ctr, int x0, int& lst) {
  if (gridDim.x == 256 && lst > 0) lst = 8;
  while (lst < 8) { const int x = (x0 + lst) & 7; const unsigned u = atomicAdd(ctr + x * 64, 1u); if (u < (unsigned)XQ_N) return x * 256 + (int)u; lst = gridDim.x == 256 ? 8 : lst + 1; }
  return -1;
}
__device__ __forceinline__ int xq_attn(int code, bool last) {
  if (code < 0) return -1;
  const int x = code >> 8, u = code & 255; int g, t;
  if (u < XQ_CB0) { if (last) return -1; g = 8 * x + (u - XQ_CA0); t = 0; }
  else if (u < XQ_CS0) { if (last) return -1; g = 8 * x + (u - XQ_CB0); t = 1; }
  else if (u < XQ_A0) return -1;
  else if (u < XQ_B0) { g = 8 * x + ((u - XQ_A0) >> 3); t = 0; }
  else if (u < XQ_S0) { g = 8 * x + ((u - XQ_B0) >> 3); t = 1; }
  else return -1;
  return (t << 12) | ((g >> 2) << 4) | (g & 3);
}
__device__ __forceinline__ void mix_phase(const Params& P, int layer, unsigned char* lds, unsigned* ctr) {
  volatile __attribute__((address_space(3))) int* shu = (volatile __attribute__((address_space(3))) int*)((__attribute__((address_space(3))) unsigned char*)lds + LDS_BYTES - 64);
  const bool last = layer == DEPTH - 1;
  const bool ctxhere = gridDim.x == 256 && !last;
  const bool local = ((volatile __attribute__((address_space(3))) unsigned*)((__attribute__((address_space(3))) unsigned char*)lds + LDS_BYTES - 32))[2] != 0u;
  unsigned* cdone = ((unsigned*)(P.ws + WS_CTL)) + 16384 + (layer * 8 + (int)(blockIdx.x & 7)) * 64;
  for (int g = (int)blockIdx.x; g < 64; g += (int)gridDim.x) {
    gla::unit(P, layer, 2 * (g & 7) + (g >> 5), (g >> 3) & 3, lds);
    if (ctxhere) {
      grp_signal(cdone, local); grp_wait(cdone, 28u, local);
      const int cu = g >> 3; OneTile T{128 + 2 * (g & 7) + (cu >> 2), cu & 3};
      pg8::Gemm gm{((bf16_t*)(P.ws + WS_Y)), ((bf16_t*)(P.ws + WS_WTOUT)) + (size_t)layer * DM * DM, MROWS, DM, DM};
      if (layer == 0) { EpiOut<true, false> E{P, layer}; pg8::gemm_phase<EpiOut<true, false>, OneTile, true, true>((PG8_LAS unsigned char*)lds, gm, T, E); }
      else { EpiOut<false, false> E{P, layer}; pg8::gemm_phase<EpiOut<false, false>, OneTile, true, true>((PG8_LAS unsigned char*)lds, gm, T, E); }
    }
  }
  __syncthreads();
  if (tid_now() == 0) { int lst = 0; const int x0 = (int)(blockIdx.x & 7); shu[0] = xq_pull(ctr, x0, lst); shu[1] = xq_pull(ctr, x0, lst); shu[2] = lst; shu[3] = 0; }
  __syncthreads();
  for (;;) {
    const int c0 = __builtin_amdgcn_readfirstlane(shu[0]);
    if (c0 < 0) break;
    unsigned pend = 0u;
    if (tid_now() == 0) { const int lst = shu[2]; if (lst < 8) pend = atomicAdd(ctr + (((int)(blockIdx.x & 7) + lst) & 7) * 64, 1u); }
    { const int x = c0 >> 8, u = c0 & 255; const int an = xq_attn(c0, last), nx = xq_attn(__builtin_amdgcn_readfirstlane(shu[1]), last); const bool pre = __builtin_amdgcn_readfirstlane(shu[3]) != 0;
      __syncthreads();
      if (tid_now() == 0) shu[3] = (an >= 0 && nx >= 0) ? 1 : 0;
      if (an >= 0) { const int b = (an >> 4) & 15, h = an & 3;
        if (u >= XQ_A0) { const int qb = (u < XQ_B0 ? u - XQ_A0 : u - XQ_B0) & 7; if ((an >> 12) == 0) att::attn_unit<0, 8>(P, layer, b, h, qb, (char*)lds, pre, nx); else att::attn_unit<1, 8>(P, layer, b, h, qb, (char*)lds, pre, nx); }
        else { if ((an >> 12) == 0) att::attn_unit<0, 8>(P, layer, b, h, 8, (char*)lds, pre, nx); else att::attn_unit<1, 8>(P, layer, b, h, 8, (char*)lds, pre, nx); } }
      else if (u >= XQ_S0) { const int ch = 32 * x + (u - XQ_S0); const SguIn si = sgu_load(P, ch); sgu_unit(P, layer, ch, si, lds); }
      else if (u >= XQ_CS0 && u < XQ_A0 && !last) { const int ch = 256 + 4 * x + (u - XQ_CS0); const SguIn si = sgu_load(P, ch); sgu_unit(P, layer, ch, si, lds); }
      if (ctxhere && u < XQ_A0) grp_signal(cdone, local); }
    __syncthreads();
    if (tid_now() == 0) { int lst = shu[2]; const int x0 = (int)(blockIdx.x & 7); int c2 = -1;
      if (lst < 8) { if (pend < (unsigned)XQ_N) c2 = ((x0 + lst) & 7) * 256 + (int)pend; else { ++lst; c2 = xq_pull(ctr, x0, lst); } }
      shu[0] = shu[1]; shu[1] = c2; shu[2] = lst; }
    __syncthreads();
  }
}

#define LAS __attribute__((address_space(3)))
#define XB_TMO      128
#define XB_XCNT(j)  (256  + 64 * (j))
#define XB_XSUB(j)  (1280 + 64 * (j))
#define XB_XGEN(j)  (2304 + 64 * (j))
#define XB_TOP      3328
#define XB_TOPGEN   3392
#define XCD_BAR_WORDS 3456
#define XB_SPIN_CAP (1u << 18)

__device__ __forceinline__ unsigned xb_ld(unsigned* p)              { return __hip_atomic_load(p, __ATOMIC_RELAXED, __HIP_MEMORY_SCOPE_AGENT); }
__device__ __forceinline__ unsigned xb_add(unsigned* p, unsigned v) { return __hip_atomic_fetch_add(p, v, __ATOMIC_RELAXED, __HIP_MEMORY_SCOPE_AGENT); }
__device__ __forceinline__ unsigned xb_xcc_id() { return (unsigned)__builtin_amdgcn_s_getreg((3 << 11) | 20) & 0xFu; }
#define XB_SPIN(cond, bar) do { unsigned _sp = 0; while (cond) { __builtin_amdgcn_s_sleep(1); \
    if ((++_sp & 255u) == 0u) { if (xb_ld(&(bar)[XB_TMO])) break; if (_sp > XB_SPIN_CAP) { atomicAdd(&(bar)[XB_TMO], 1u); break; } } } } while (0)

struct XcdBarrier {
    unsigned* bar; unsigned x;
    volatile LAS unsigned* st;
};

__device__ __forceinline__ XcdBarrier xcd_barrier_post(unsigned* bar, volatile LAS unsigned* st) {
    XcdBarrier b; b.bar = bar; b.x = xb_xcc_id(); b.st = st;
    if (threadIdx.x == 0) (void)xb_add(&bar[XB_XCNT(b.x)], 1u);
    return b;
}
__device__ __forceinline__ void xcd_barrier_complete(unsigned* bar, unsigned x, unsigned& nloc, unsigned& nx) {
    const unsigned G = gridDim.x * gridDim.y * gridDim.z;
    unsigned sum, cnt, mine, sp = 0u;
    for (;;) {
        sum = 0u; cnt = 0u; mine = 0u;
#pragma unroll
        for (unsigned j = 0; j < 16; ++j) { const unsigned c = xb_ld(&bar[XB_XCNT(j)]); sum += c; cnt += (c > 0u) ? 1u : 0u; mine = (j == x) ? c : mine; }
        if (sum == G) break;
        __builtin_amdgcn_s_sleep(1);
        if ((++sp & 255u) == 0u) { if (xb_ld(&bar[XB_TMO])) break; if (sp > XB_SPIN_CAP) { atomicAdd(&bar[XB_TMO], 1u); break; } }
    }
    nloc = mine > 0u ? mine : 1u; nx = cnt > 0u ? cnt : 1u;
}

__device__ __forceinline__ void xcd_barrier(const XcdBarrier& b) {
    asm volatile("s_waitcnt vmcnt(0)" ::: "memory");
    __syncthreads();
    if (threadIdx.x == 0) {
        unsigned* bar = b.bar;
        __builtin_amdgcn_s_waitcnt(0);
        unsigned nloc = b.st[0], nx = b.st[1];
        if (nloc == 0u) { xcd_barrier_complete(bar, b.x, nloc, nx); b.st[0] = nloc; b.st[1] = nx; }
        const unsigned old = xb_add(&bar[XB_XSUB(b.x)], 1u);
        const unsigned gen = old / nloc;
        if (old + 1u == (gen + 1u) * nloc) {
            __builtin_amdgcn_fence(__ATOMIC_RELEASE, "agent");
            asm volatile("s_waitcnt vmcnt(0)" ::: "memory");
            const unsigned og = xb_add(&bar[XB_TOP], 1u);
            const unsigned tg = og / nx;
            if (og + 1u == (tg + 1u) * nx) xb_add(&bar[XB_TOPGEN], 1u);
            else XB_SPIN(xb_ld(&bar[XB_TOPGEN]) == tg, bar);
            __builtin_amdgcn_fence(__ATOMIC_ACQUIRE, "agent");
            xb_add(&bar[XB_XGEN(b.x)], 1u);
            asm volatile("s_waitcnt vmcnt(0)" ::: "memory");
        } else {
            XB_SPIN(xb_ld(&bar[XB_XGEN(b.x)]) == gen, bar);
            __builtin_amdgcn_fence(__ATOMIC_ACQUIRE, "agent");
            asm volatile("s_waitcnt vmcnt(0)" ::: "memory");
        }
    }
    __syncthreads();
}

__device__ __forceinline__ unsigned l2_add(unsigned* p, unsigned v) { unsigned r; asm volatile("global_atomic_add %0, %1, %2, off sc0\n\ts_waitcnt vmcnt(0)" : "=&v"(r) : "v"(p), "v"(v) : "memory"); return r; }
__device__ __forceinline__ void xgroup_barrier(unsigned* cnt, bool local) {
  asm volatile("s_waitcnt vmcnt(0)" ::: "memory");
  __syncthreads();
  if (threadIdx.x == 0) {
    unsigned sp = 0u;
    if (local) {
      const unsigned old = l2_add(cnt, 1u); const unsigned tgt = (old / 32u + 1u) * 32u;
      while (l2_add(cnt, 0u) < tgt) { __builtin_amdgcn_s_sleep(1); if (++sp > (1u << 20)) break; }
    } else {
      __builtin_amdgcn_fence(__ATOMIC_RELEASE, "agent");
      asm volatile("s_waitcnt vmcnt(0)" ::: "memory");
      const unsigned old = __hip_atomic_fetch_add(cnt, 1u, __ATOMIC_RELAXED, __HIP_MEMORY_SCOPE_AGENT); const unsigned tgt = (old / 32u + 1u) * 32u;
      while (__hip_atomic_load(cnt, __ATOMIC_RELAXED, __HIP_MEMORY_SCOPE_AGENT) < tgt) { __builtin_amdgcn_s_sleep(1); if (++sp > (1u << 22)) break; }
    }
    __builtin_amdgcn_fence(__ATOMIC_ACQUIRE, "agent");
    asm volatile("s_waitcnt vmcnt(0)" ::: "memory");
  }
  __syncthreads();
}
__global__ void __launch_bounds__(NTHREADS, 2) mega(Params P) {
  extern __shared__ __attribute__((aligned(16))) unsigned char lds[];
  cg::grid_group grid = cg::this_grid();
  float* ldsf = (float*)lds;
  volatile LAS unsigned* xst = (volatile LAS unsigned*)((LAS unsigned char*)lds + LDS_BYTES - 32);
  if (threadIdx.x < 2) xst[threadIdx.x] = 0u;
  __syncthreads();
  (void)xcd_barrier_post(((unsigned*)(P.ws + WS_CTL)) + 4096, xst);
  if (threadIdx.x == 0) __hip_atomic_store(((unsigned*)(P.ws + WS_CTL)) + 65536 + blockIdx.x, xb_xcc_id() + 1u, __ATOMIC_RELAXED, __HIP_MEMORY_SCOPE_AGENT);
#define GSYNC() do { XcdBarrier xb_; xb_.bar = ((unsigned*)(P.ws + WS_CTL)) + 4096; xb_.x = xb_xcc_id(); xb_.st = (volatile LAS unsigned*)((LAS unsigned char*)lds + LDS_BYTES - 32); xcd_barrier(xb_); } while (0)
  p0_mod(P, ldsf); p0_tables(P); p0_fold(P); p0_weights<0>(P, ldsf, 0, 1, 0);
  if (P.ws == nullptr) grid.sync();
  GSYNC();
  p0_weights<1>(P, ldsf, 0, 1, 0); __syncthreads(); p0_bias(P, ldsf, 0, DEPTH, 0); p0_xs(P);
  GSYNC();
  if (threadIdx.x == 0) { unsigned same = gridDim.x == 256 ? 1u : 0u; const unsigned mine = xb_xcc_id() + 1u;
    if (same) for (int j = 0; j < 32; ++j) same &= (__hip_atomic_load(((unsigned*)(P.ws + WS_CTL)) + 65536 + j * 8 + (blockIdx.x & 7), __ATOMIC_RELAXED, __HIP_MEMORY_SCOPE_AGENT) == mine) ? 1u : 0u;
    xst[2] = same; }
  __syncthreads();
#define XSYNC() do { if (gridDim.x == 256) xgroup_barrier(((unsigned*)(P.ws + WS_CTL)) + 8192 + 64 * (blockIdx.x & 7), ((volatile LAS unsigned*)((LAS unsigned char*)lds + LDS_BYTES - 32))[2] != 0u); else GSYNC(); } while (0)
  for (int i = tid_now(); i < 3080; i += NTHREADS) ((float*)(lds + LDS_TAB))[i] = ((float*)(P.ws + WS_TAB))[i];
  Params Pl = P;
#define OPQ() do { __attribute__((address_space(1))) unsigned char* g_ = (__attribute__((address_space(1))) unsigned char*)Pl.ws; asm volatile("" : "+s"(g_)); Pl.ws = (unsigned char*)g_; } while (0)
  for (int layer = 0; layer < DEPTH; ++layer) {
    OPQ();
    { EpiIn E{Pl, layer, (const float*)(lds + LDS_RSTD), (const float*)(lds + LDS_TAB), (const float*)(lds + LDS_BIASU), (const float*)(lds + LDS_QKN)}; pg8::Gemm g{((bf16_t*)(Pl.ws + WS_XS)), ((bf16_t*)(Pl.ws + WS_WTIN)) + (size_t)layer * NPROJ * DM, MROWS, NPROJ, DM}; pg8::XcdOrder S; int bid_ = (int)blockIdx.x; asm volatile("" : "+s"(bid_)); if (gridDim.x == 256) S.init(18, NPROJ / 256, 32, bid_ >> 3, 16 * (bid_ & 7), 128 + 2 * (bid_ & 7), 16); else S.init(MROWS / 256, NPROJ / 256, (int)gridDim.x, bid_, 0, 128, 128);
      { const int t_ = tid_now(); pg8::Unit u_;
#pragma unroll
        for (int ui = 0; ui < 8; ++ui) if (S.next(ui, u_) && t_ < 256) { const f32x4* sp = (const f32x4*)(((float*)(Pl.ws + WS_SSP)) + (size_t)(u_.pm * 256 + t_) * 16); const f32x4 s0 = sp[0], s1 = sp[1], s2 = sp[2], s3 = sp[3];
          const float ssq = ((s0.x + s0.y) + (s0.z + s0.w)) + ((s1.x + s1.y) + (s1.z + s1.w)) + ((s2.x + s2.y) + (s2.z + s2.w)) + ((s3.x + s3.y) + (s3.z + s3.w));
          ((float*)(lds + LDS_BIASU))[ui * 256 + t_] = ((float*)(Pl.ws + WS_BIAS))[(size_t)(layer * 17 + (u_.pm < 128 ? (u_.pm >> 3) : 16)) * NPROJ + u_.pn * 256 + t_];
          ((float*)(lds + LDS_RSTD))[ui * 256 + t_] = rsqrtf(ssq * (1.f / DM) + EPS); }
        if (t_ >= 256 && t_ < 384) ((float*)(lds + LDS_QKN))[t_ - 256] = PVEC(Pl)[(t_ < 320 ? PV_QN : PV_KN) + layer * 64 + (t_ & 63)];
        __syncthreads(); }
      pg8::gemm_phase<EpiIn, pg8::XcdOrder, true, true>((PG8_LAS unsigned char*)lds, g, S, E);
    }
    XSYNC(); OPQ();
    mix_phase(Pl, layer, lds, ((unsigned*)(Pl.ws + WS_CTL)) + 512 * layer);
    XSYNC(); OPQ();
    { const int Mo = layer == DEPTH - 1 ? NLAT : MROWS; pg8::Gemm g{((bf16_t*)(Pl.ws + WS_Y)), ((bf16_t*)(Pl.ws + WS_WTOUT)) + (size_t)layer * DM * DM, Mo, DM, DM}; pg8::XcdOrder S; int bid_ = (int)blockIdx.x; asm volatile("" : "+s"(bid_)); if (gridDim.x == 256) S.init(16, DM / 256, 32, bid_ >> 3, 16 * (bid_ & 7), 128 + 2 * (bid_ & 7), 16); else S.init(Mo / 256, DM / 256, (int)gridDim.x, bid_, 0, 128, 128);
      if (layer == 0) { EpiOut<true, false> E{Pl, layer}; pg8::gemm_phase<EpiOut<true, false>, pg8::XcdOrder, true, true>((PG8_LAS unsigned char*)lds, g, S, E); }
      else if (layer < DEPTH - 1) { EpiOut<false, false> E{Pl, layer}; pg8::gemm_phase<EpiOut<false, false>, pg8::XcdOrder, true, true>((PG8_LAS unsigned char*)lds, g, S, E); }
      else { EpiOut<false, true> E{Pl, layer}; pg8::gemm_phase<EpiOut<false, true>, pg8::XcdOrder, true, true>((PG8_LAS unsigned char*)lds, g, S, E); }
      if (layer < DEPTH - 1) { const int b0 = 0; __syncthreads(); p0_weights<2>(Pl, (float*)lds, layer + 1, layer + 2, b0);
        if (gridDim.x == 256 && (int)blockIdx.x >= b0) { asm volatile("s_waitcnt vmcnt(0)" ::: "memory"); __syncthreads();
          if (threadIdx.x == 0) { __builtin_amdgcn_fence(__ATOMIC_RELEASE, "agent"); asm volatile("s_waitcnt vmcnt(0)" ::: "memory"); (void)xb_add(((unsigned*)(Pl.ws + WS_CTL)) + 12288 + 64 * (layer + 1), 1u); } } } }
    if (layer < DEPTH - 1) XSYNC(); else GSYNC();
    OPQ();
    if (gridDim.x == 256 && layer < DEPTH - 1) {
      if (threadIdx.x == 0) { unsigned sp = 0u; while (xb_ld(((unsigned*)(Pl.ws + WS_CTL)) + 12288 + 64 * (layer + 1)) < 256u) { __builtin_amdgcn_s_sleep(1); if (++sp > (1u << 22)) break; }
        __builtin_amdgcn_fence(__ATOMIC_ACQUIRE, "agent"); asm volatile("s_waitcnt vmcnt(0)" ::: "memory"); }
      __syncthreads(); }
  }
  final_norm(P);
}

extern "C" void kernel_launch(void* const* d_in, const int* in_sizes, int n_in, void* d_out, int out_size, void* d_ws, size_t ws_size, hipStream_t stream) {
  static int grid_blocks = 0;
  if (!grid_blocks) {
    int dev = 0, cus = 0, per_cu = 0;
    (void)hipGetDevice(&dev);
    (void)hipDeviceGetAttribute(&cus, hipDeviceAttributeMultiprocessorCount, dev);
    (void)hipFuncSetAttribute((const void*)mega, hipFuncAttributeMaxDynamicSharedMemorySize, LDS_BYTES);
    (void)hipOccupancyMaxActiveBlocksPerMultiprocessor(&per_cu, (const void*)mega, NTHREADS, LDS_BYTES);
    if (per_cu < 1) per_cu = 1;
    grid_blocks = cus * per_cu;
    if (ws_size < WS_END || n_in != 26) { fprintf(stderr, "kernel_launch: bad ws_size %zu / n_in %d\n", ws_size, n_in); grid_blocks = -1; }
  }
  if (grid_blocks < 0) return;
  (void)hipMemsetAsync((char*)d_ws + WS_CTL, 0, 1 * MiB, stream);
  Params p{};
  const float** pin = (const float**)&p;
  for (int i = 0; i < 26; ++i) pin[i] = (const float*)d_in[i];
  unsigned char* ws = (unsigned char*)d_ws;
  p.out = (float*)d_out;
  p.ws = ws;
  void* args[] = {&p};
  hipError_t e = hipLaunchCooperativeKernel((void*)mega, dim3(grid_blocks), dim3(NTHREADS), args, LDS_BYTES, stream);
  if (e != hipSuccess) fprintf(stderr, "cooperative launch failed: %s (grid %d)\n", hipGetErrorString(e), grid_blocks);
}
```

```cpp
#include <hip/hip_runtime.h>
#include <hip/hip_cooperative_groups.h>
#include <cstdio>
#include <cstdint>
namespace cg = cooperative_groups;

typedef unsigned short bf16_t;
typedef float f32x4 __attribute__((ext_vector_type(4)));
typedef unsigned u32x4 __attribute__((ext_vector_type(4)));
typedef unsigned u32x2 __attribute__((ext_vector_type(2)));

constexpr int NTHREADS = 512;
constexpr int LDS_BYTES = 163840;
constexpr int LDS_RSTD = 131072, LDS_TAB = 139264, LDS_BIASU = 151584, LDS_QKN = 159776;
constexpr int DM = 1024, SEQ = 2048, NB = 16, CTXL = 256, DEPTH = 4;
constexpr int NLAT = NB * SEQ, NCTX = NB * CTXL, MROWS = NLAT + NCTX;
constexpr int PINW = 3360, NPROJ = 3584;
constexpr float EPS = 1e-6f;
constexpr float LOG2E = 1.4426950408889634f;
constexpr int C_AQ = 0, C_AK = 256, C_AV = 512, C_AZ = 768, C_BQ = 1024, C_BK = 1280, C_BV = 1408, C_BZ = 1536,
              C_CU = 1792, C_CV = 2048, C_CZ = 2304, C_DQ = 2560, C_DK = 2688, C_DV = 2816, C_DZ = 3072;
constexpr size_t MiB = 1u << 20;
constexpr size_t WS_CTL = 0, WS_MOD = 1 * MiB, WS_BIAS = 2 * MiB, WS_TAB = 3 * MiB, WS_SSP = 4 * MiB, WS_WTIN = 8 * MiB, WS_WTOUT = 36 * MiB,
                 WS_XC = 44 * MiB, WS_XS = 64 * MiB, WS_Y = 136 * MiB, WS_PROJ = 208 * MiB, WS_GATE = 460 * MiB, WS_WG = 496 * MiB, WS_DVEC = 500 * MiB, WS_END = 502 * MiB;

struct Params {
  const float *x, *c, *ctx, *c_ctx, *ada_w, *ada_b, *norm_g, *w_in, *lq1, *lk1, *lq2, *lk2, *subln_g, *qn_g, *kn_g,
      *ln_g, *ln_b, *sg_w, *sg_b, *w2_f, *b_f, *w2_b, *b_b, *gla_g, *w_out, *final_g;
  float* out;
  unsigned char* ws;
};
constexpr int T_COSA = 0, T_SINA = 512, T_COSB = 1024, T_SINB = 2048, T_LAM = 3072, T_LAMI = 3076;
constexpr size_t WS_PV = WS_TAB + 16384, WS_SGW = WS_TAB + 65536;
constexpr int PV_SUBLN = 0, PV_QN = 256, PV_KN = 512, PV_GLAG = 768, PV_LNG = 1024, PV_LNB = 2048, PV_SGB = 3072, PV_NORMG = 5120, PV_TOTAL = 9216;
#define PVEC(P) ((const float*)((P).ws + WS_PV))

__device__ __forceinline__ unsigned f2bf(float f) { unsigned u = __builtin_bit_cast(unsigned, f); return (u + 0x7fffu + ((u >> 16) & 1u)) >> 16; }
typedef float f32x2_c __attribute__((ext_vector_type(2))); typedef __bf16 bf16x2_c __attribute__((ext_vector_type(2)));
__device__ __forceinline__ unsigned pk2(float lo, float hi) { const f32x2_c v = {lo, hi}; return __builtin_bit_cast(unsigned, __builtin_convertvector(v, bf16x2_c)); }
__device__ __forceinline__ float bflo(unsigned w) { return __builtin_bit_cast(float, w << 16); }
__device__ __forceinline__ float bfhi(unsigned w) { return __builtin_bit_cast(float, w & 0xffff0000u); }
__device__ __forceinline__ float bf2f(bf16_t h) { return __builtin_bit_cast(float, (unsigned)h << 16); }
__device__ __forceinline__ float wave_sum(float v) {
#pragma unroll
  for (int o = 1; o < 64; o <<= 1) v += __shfl_xor(v, o);
  return v;
}
__device__ __forceinline__ float siluf(float v) { return v * __builtin_amdgcn_rcpf(1.f + __expf(-v)); }
__device__ __forceinline__ int vi_now() { int bx = (int)blockIdx.x; asm volatile("" : "+s"(bx)); return (bx & 7) * 32 + (bx >> 3); }
__device__ __forceinline__ int tid_now() { int t = threadIdx.x; asm volatile("" : "+v"(t)); return t; }

__device__ __forceinline__ int colmap(int n) {
  const int pn = n >> 8, p = n & 255;
  if (pn <= 1) { const int e = p & 31, s = e >> 4, w = e & 15; return (n & ~31) + s * 16 + (w >> 1) + 8 * (w & 1); }
  if (pn == 4 || pn == 5) {
    const int bj = p >> 7, wc = (p >> 5) & 3, e = p & 31;
    if (pn == 4) return C_BQ + wc * 64 + bj * 32 + (e >> 1) + 16 * (e & 1);
    if (wc < 2) return C_BK + wc * 64 + bj * 32 + (e >> 1) + 16 * (e & 1);
    return C_BV + (wc - 2) * 64 + bj * 32 + e;
  }
  return n;
}
__device__ __forceinline__ float weff(const Params& P, int i, int k, int n) {
  const float* wrow = P.w_in + ((size_t)i * DM + k) * PINW;
  if (n < 3328) return wrow[colmap(n)];
  return ((float*)(P.ws + WS_WG))[((size_t)i * DM + k) * 256 + (n - 3328)];
}
__device__ __forceinline__ void p0_fold(const Params& P) {
  const int gt = blockIdx.x * NTHREADS + threadIdx.x, NG = gridDim.x * NTHREADS;
  for (int idx = gt; idx < DEPTH * DM * 256; idx += NG) {
    const int p = idx & 255, k = (idx >> 8) & 1023, i = idx >> 18, dir = p >> 7, j = p & 127;
    const float* w2 = (dir ? P.w2_b : P.w2_f) + (size_t)i * 16 * 128 + j;
    const float* r = P.w_in + ((size_t)i * DM + k) * PINW + 3328 + dir * 16;
    float s = 0.f;
#pragma unroll
    for (int q = 0; q < 16; ++q) s += r[q] * w2[q * 128];
    ((float*)(P.ws + WS_WG))[idx] = s;
  }
}

__device__ __forceinline__ void p0_mod(const Params& P, float* ldsf) {
  float* sc = ldsf;
  float* red = ldsf + 17 * 1024;
  const int tid = threadIdx.x;
  for (int u = blockIdx.x; u < 192; u += gridDim.x) {
    __syncthreads();
    for (int idx = tid; idx < 17 * 1024; idx += NTHREADS) { const int bb = idx >> 10, k = idx & 1023; const float c = bb < 16 ? P.c[bb * 1024 + k] : P.c_ctx[k]; sc[idx] = c / (1.f + expf(-c)); }
    __syncthreads();
    const int kc = tid >> 6, cl = tid & 63; const int cgl = u * 64 + cl; const int i = cgl / 3072, col = cgl % 3072;
    float acc[17];
#pragma unroll
    for (int bb = 0; bb < 17; ++bb) acc[bb] = 0.f;
    const float* w = P.ada_w + ((size_t)i * 1024 + kc * 128) * 3072 + col;
#pragma unroll 8
    for (int k = 0; k < 128; ++k) { const float wv = w[(size_t)k * 3072];
#pragma unroll
      for (int bb = 0; bb < 17; ++bb) acc[bb] += sc[bb * 1024 + kc * 128 + k] * wv; }
#pragma unroll
    for (int bb = 0; bb < 17; ++bb) red[(kc * 17 + bb) * 64 + cl] = acc[bb];
    __syncthreads();
    for (int idx = tid; idx < 17 * 64; idx += NTHREADS) { const int bb = idx >> 6, c2 = idx & 63; float s = 0.f;
#pragma unroll
      for (int q = 0; q < 8; ++q) s += red[(q * 17 + bb) * 64 + c2];
      const int cg2 = u * 64 + c2; const int i2 = cg2 / 3072, col2 = cg2 % 3072; ((float*)(P.ws + WS_MOD))[(size_t)(i2 * 17 + bb) * 3072 + col2] = s + P.ada_b[i2 * 3072 + col2]; }
  }
  __syncthreads();
}
__device__ __forceinline__ void p0_tables(const Params& P) {
  { const int gt = blockIdx.x * NTHREADS + threadIdx.x, NG = gridDim.x * NTHREADS; float* pv = (float*)(P.ws + WS_PV);
    for (int i = gt; i < PV_TOTAL; i += NG) { float v;
      if (i < PV_QN) v = P.subln_g[i]; else if (i < PV_KN) v = P.qn_g[i - PV_QN]; else if (i < PV_GLAG) v = P.kn_g[i - PV_KN]; else if (i < PV_LNG) v = P.gla_g[i - PV_GLAG];
      else if (i < PV_LNB) v = P.ln_g[i - PV_LNG]; else if (i < PV_SGB) v = P.ln_b[i - PV_LNB]; else if (i < PV_NORMG) v = P.sg_b[i - PV_SGB]; else v = P.norm_g[i - PV_NORMG];
      pv[i] = v; }
    bf16_t* sw = (bf16_t*)(P.ws + WS_SGW);
    for (int i = gt; i < DEPTH * 4 * 128 * 128 / 2; i += NG) { const float2 w = ((const float2*)P.sg_w)[i]; ((unsigned*)sw)[i] = pk2(w.x, w.y); } }
  if (blockIdx.x != gridDim.x - 1) return;
  const int tid = threadIdx.x;
  { const int pos = tid >> 3, j = tid & 7; const float inv = powf(10000.f, -(float)j / 8.f); const float a = (float)pos * inv; ((float*)(P.ws + WS_TAB))[T_COSA + tid] = cosf(a); ((float*)(P.ws + WS_TAB))[T_SINA + tid] = sinf(a); }
  for (int idx = tid; idx < 1024; idx += NTHREADS) { const int pos = idx >> 4, j = idx & 15; const float inv = powf(10000.f, -(float)j / 16.f); const float a = (float)pos * inv; ((float*)(P.ws + WS_TAB))[T_COSB + idx] = cosf(a); ((float*)(P.ws + WS_TAB))[T_SINB + idx] = sinf(a); }
  if (tid < 4) { float s1 = 0.f, s2 = 0.f; for (int d = 0; d < 32; ++d) { s1 += P.lq1[tid * 32 + d] * P.lk1[tid * 32 + d]; s2 += P.lq2[tid * 32 + d] * P.lk2[tid * 32 + d]; }
    const float li = (float)(0.8 - 0.6 * exp(-0.3 * (double)tid)); ((float*)(P.ws + WS_TAB))[T_LAM + tid] = expf(s1) - expf(s2) + li; ((float*)(P.ws + WS_TAB))[T_LAMI + tid] = li; }
}
template <int PART>
__device__ __forceinline__ void p0_weights(const Params& P, float* ldsf, int l0, int l1, int b0) {
  const int tid = tid_now(), lane = tid & 63, wave = tid >> 6;
  float* scr = ldsf + wave * (64 * 33);
  if ((int)blockIdx.x < b0) return;
  const int gw = ((int)blockIdx.x - b0) * 8 + wave, NGW = ((int)gridDim.x - b0) * 8;
  constexpr int I_IN = 16 * (NPROJ / 32), I_OUT = 16 * (DM / 32);
  const int NIT = (l1 - l0) * (I_IN + I_OUT);
  for (int it = gw; it < NIT; it += NGW) {
    const int i = l0 + it / (I_IN + I_OUT); int r = it % (I_IN + I_OUT);
    const bool isin = r < I_IN; if (!isin) r -= I_IN;
    const int nblk = isin ? NPROJ / 32 : DM / 32; const int kb = r / nblk, nb = r % nblk, k0 = 64 * kb, n0 = 32 * nb;
    if (PART != 2 && (isin && n0 >= 3328) != (PART == 1)) continue;
#pragma unroll 8
    for (int q = 0; q < 32; ++q) { const int kk = 2 * q + (lane >> 5), nn = lane & 31;
      scr[kk * 33 + nn] = isin ? weff(P, i, k0 + kk, n0 + nn) : P.w_out[((size_t)i * DM + k0 + kk) * DM + n0 + nn]; }
    asm volatile("s_waitcnt lgkmcnt(0)" ::: "memory");
    const int c = lane & 7;
    bf16_t* WT = isin ? ((bf16_t*)(P.ws + WS_WTIN)) + (size_t)i * NPROJ * DM : ((bf16_t*)(P.ws + WS_WTOUT)) + (size_t)i * DM * DM;
#pragma unroll
    for (int j = 0; j < 4; ++j) { const int n = (lane >> 3) + 8 * j; const float* s = scr + (8 * c) * 33 + n;
      u32x4 o; o.x = pk2(s[0 * 33], s[1 * 33]); o.y = pk2(s[2 * 33], s[3 * 33]); o.z = pk2(s[4 * 33], s[5 * 33]); o.w = pk2(s[6 * 33], s[7 * 33]);
      *(u32x4*)(WT + (size_t)(n0 + n) * DM + k0 + 8 * c) = o; }
    asm volatile("s_waitcnt lgkmcnt(0)" ::: "memory");
  }
}
__device__ __forceinline__ void p0_bias(const Params& P, float* ldsf, int l0, int l1, int b0) {
  float* sh = ldsf;
  float* red = ldsf + 17 * 1024;
  const int tid = tid_now();
  if ((int)blockIdx.x < b0) return;
  for (int u = (int)blockIdx.x - b0; u < (l1 - l0) * 56; u += (int)gridDim.x - b0) {
    const int i = l0 + u / 56, nb = u % 56;
    __syncthreads();
    for (int idx = tid; idx < 17 * 1024; idx += NTHREADS) { const int bb = idx >> 10, k = idx & 1023; sh[idx] = ((float*)(P.ws + WS_MOD))[(size_t)(i * 17 + bb) * 3072 + k]; }
    __syncthreads();
    const int kc = tid >> 6, cl = tid & 63; const int n = nb * 64 + cl;
    float acc[17];
#pragma unroll
    for (int bb = 0; bb < 17; ++bb) acc[bb] = 0.f;
#pragma unroll 8
    for (int k = 0; k < 128; ++k) { const float wv = weff(P, i, kc * 128 + k, n);
#pragma unroll
      for (int bb = 0; bb < 17; ++bb) acc[bb] += sh[bb * 1024 + kc * 128 + k] * wv; }
#pragma unroll
    for (int bb = 0; bb < 17; ++bb) red[(kc * 17 + bb) * 64 + cl] = acc[bb];
    __syncthreads();
    for (int idx = tid; idx < 17 * 64; idx += NTHREADS) { const int bb = idx >> 6, c2 = idx & 63; float s = 0.f;
#pragma unroll
      for (int q = 0; q < 8; ++q) s += red[(q * 17 + bb) * 64 + c2];
      const int n2 = nb * 64 + c2;
      if (n2 >= 3328) { const int p = n2 - 3328; s += (p >> 7) ? P.b_b[i * 128 + (p & 127)] : P.b_f[i * 128 + (p & 127)]; }
      ((float*)(P.ws + WS_BIAS))[(size_t)(i * 17 + bb) * NPROJ + n2] = s; }
  }
  __syncthreads();
}
__device__ __forceinline__ void p0_xs(const Params& P) {
  const int tid = threadIdx.x, lane = tid & 63, wave = tid >> 6;
  const int gw = blockIdx.x * 8 + wave, NGW = gridDim.x * 8;
  f32x4 g[4];
#pragma unroll
  for (int j = 0; j < 4; ++j) g[j] = *(const f32x4*)(P.norm_g + 4 * (lane + 64 * j));
  for (int row0 = gw * 2; row0 < MROWS; row0 += NGW * 2) {
    const float* src = row0 < NLAT ? P.x + (size_t)row0 * DM : P.ctx + (size_t)(row0 - NLAT) * DM;
    const int bb = row0 < NLAT ? (row0 >> 11) : 16;
    const float* sc = ((float*)(P.ws + WS_MOD)) + (size_t)bb * 3072 + 1024;
    f32x4 v[2][4], sv[4];
#pragma unroll
    for (int j = 0; j < 4; ++j) { const int k = 4 * (lane + 64 * j); sv[j] = *(const f32x4*)(sc + k); v[0][j] = __builtin_nontemporal_load((const f32x4*)(src + k)); v[1][j] = __builtin_nontemporal_load((const f32x4*)(src + DM + k)); }
#pragma unroll
    for (int r = 0; r < 2; ++r) { float ss = 0.f;
#pragma unroll
      for (int j = 0; j < 4; ++j) { const int k = 4 * (lane + 64 * j); const f32x4 x = v[r][j], gg = g[j], s = sv[j];
        ss += x.x * x.x + x.y * x.y + x.z * x.z + x.w * x.w;
        u32x2 o; o.x = pk2(x.x * gg.x * (1.f + s.x), x.y * gg.y * (1.f + s.y)); o.y = pk2(x.z * gg.z * (1.f + s.z), x.w * gg.w * (1.f + s.w));
        *(u32x2*)(((bf16_t*)(P.ws + WS_XS)) + (size_t)(row0 + r) * DM + k) = o; }
      ss = wave_sum(ss);
      if (lane < 16) ((float*)(P.ws + WS_SSP))[(size_t)lane * MROWS + row0 + r] = lane == 0 ? ss : 0.f; }
  }
}

namespace pg8 {
#define PG8_LAS __attribute__((address_space(3)))
typedef unsigned short bf16_t;
typedef short bf16x8 __attribute__((ext_vector_type(8)));
typedef float f32x4 __attribute__((ext_vector_type(4)));
typedef unsigned u32x4 __attribute__((ext_vector_type(4)));
constexpr int BM = 256, BK = 64, HALF = 128, HTB = HALF * BK * 2  , STAGE_BYTES = 8 * HTB, NXCD = 8, WGM = 8;

__host__ __device__ __forceinline__ int lds_byte(int r, int c) { const int st = (r >> 4) * 2 + (c >> 5), rr = r & 15, cc = c & 31, ob = rr * 64 + cc * 2; return st * 1024 + (ob ^ (((ob >> 9) & 1) << 5)); }
__host__ __device__ __forceinline__ void stage_rc(int b, int& R, int& C) { const int st = b / 1024, sb = b % 1024, swz = sb ^ (((sb >> 9) & 1) << 5); R = (st >> 1) * 16 + swz / 64; C = (st & 1) * 32 + (swz % 64) / 2; }
__host__ __device__ __forceinline__ int perm32(int rho) { const int n = rho >> 4, i = rho & 15; return 8 * (i >> 2) + 4 * n + (i & 3); }

struct Unit { int pm, pn; };
struct Gemm { const bf16_t* A; const bf16_t* Bt; int M, N, K; };

struct StaticOrder {
    int nM, nN, nwg, G, c;
    __host__ __device__ void init(int M, int N, int G_, int c_) { nM = M / BM; nN = N / BM; nwg = nM * nN; G = G_; c = c_; }
    __host__ __device__ bool next(int i, Unit& u) const {
        const long L = (long)i * G + c; if (L >= nwg) return false;
        int wgid = (int)L; { const int q = nwg / NXCD, r = nwg % NXCD, xcd = wgid % NXCD, off = wgid / NXCD; wgid = (xcd < r ? xcd * (q + 1) : r * (q + 1) + (xcd - r) * q) + off; }
        const int nig = WGM * nN, gid = wgid / nig, fm = gid * WGM, gsz = (nM - fm) < WGM ? (nM - fm) : WGM;
        u.pm = fm + ((wgid % nig) % gsz); u.pn = (wgid % nig) / gsz; return true;
    }
    __device__ __forceinline__ void a_ready(const Unit&) const {}
    __device__ __forceinline__ void done(const Unit&) const {}
};
struct XcdOrder {
    int nMl, nN, G, c, rb0, cb0, nlat;
    __device__ __forceinline__ void init(int nMl_, int nN_, int G_, int c_, int rb0_, int cb0_, int nlat_) { nMl = nMl_; nN = nN_; G = G_; c = c_; rb0 = rb0_; cb0 = cb0_; nlat = nlat_; }
    __device__ __forceinline__ bool next(int i, Unit& u) const {
        const int L = i * G + c; if (L >= nMl * nN) return false;
        const int nig = WGM * nN, gid = L / nig, fm = gid * WGM, gsz = (nMl - fm) < WGM ? (nMl - fm) : WGM;
        const int pl = fm + ((L % nig) % gsz); u.pn = (L % nig) / gsz; u.pm = pl < nlat ? rb0 + pl : cb0 + (pl - nlat); return true;
    }
    __device__ __forceinline__ void a_ready(const Unit&) const {}
    __device__ __forceinline__ void done(const Unit&) const {}
};


template <class Epi, class Sched, bool ALIGN_EPI = false, bool SP2 = false>
__device__ __forceinline__ void gemm_phase(PG8_LAS unsigned char* lds, const Gemm g, const Sched& S, const Epi& E) {
    const int tid = tid_now(), wid = __builtin_amdgcn_readfirstlane(tid >> 6), lane = tid & 63, wr = wid >> 2, wc = wid & 3, fr = lane & 15, fq = lane >> 4;
    const int K = g.K, nt = K / BK;
    unsigned voffA[2], voffB[2];
#pragma unroll
    for (int i = 0; i < 2; ++i) { int R, C; stage_rc(tid * 16 + i * 8192, R, C); const int Rb = Epi::PERM ? ((R & ~31) + perm32(R & 31)) : R;
        voffA[i] = (unsigned)(R * K + C) * 2u; voffB[i] = (unsigned)(Rb * K + C) * 2u; }
    const size_t kstep = (size_t)(BK * 2);
    const size_t hstep = (size_t)HALF * K * 2;
    const size_t tstep = 2 * hstep;
    const unsigned ldsw = (unsigned)wid * 1024u;
    const int aoff = lds_byte(wr * 64 + fr, fq * 8), boff = lds_byte(wc * 32 + fr, fq * 8);
#define PG8_SA(b, h) (((b) * 2 + (h)) * HTB)
#define PG8_SB(b, h) ((4 + (b) * 2 + (h)) * HTB)
#define PG8_STAGE(bufoff, gbase, voff) do { _Pragma("unroll") for (int _i = 0; _i < 2; ++_i) \
        __builtin_amdgcn_global_load_lds((const unsigned*)((const char*)(gbase) + (voff)[_i]), (PG8_LAS unsigned*)(lds + (bufoff) + ldsw + _i * 8192), 16, 0, 0); } while (0)
#define PG8_LDA(dst, b, h) do { _Pragma("unroll") for (int m = 0; m < 4; ++m) _Pragma("unroll") for (int k = 0; k < 2; ++k) dst[m][k] = *(const PG8_LAS bf16x8*)(lds + PG8_SA(b, h) + aoff + m * 2048 + k * 1024); } while (0)
#define PG8_LDB(dst, b, h) do { _Pragma("unroll") for (int n = 0; n < 2; ++n) _Pragma("unroll") for (int k = 0; k < 2; ++k) dst[n][k] = *(const PG8_LAS bf16x8*)(lds + PG8_SB(b, h) + boff + n * 2048 + k * 1024); } while (0)
#define PG8_MMA(ai, bj, At, Bt) do { __builtin_amdgcn_s_setprio(1); _Pragma("unroll") for (int m = 0; m < 4; ++m) _Pragma("unroll") for (int n = 0; n < 2; ++n) _Pragma("unroll") for (int k = 0; k < 2; ++k) \
        acc[ai][bj][m][n] = __builtin_amdgcn_mfma_f32_16x16x32_bf16(Bt[n][k], At[m][k], acc[ai][bj][m][n], 0, 0, 0); __builtin_amdgcn_s_setprio(0); } while (0)
#define PG8_WAIT_V(n) asm volatile("s_waitcnt vmcnt(" #n ")" ::: "memory")
#define PG8_WAIT_L(n) asm volatile("s_waitcnt lgkmcnt(" #n ")" ::: "memory")
#define PG8_BAR __builtin_amdgcn_s_barrier()
#define PG8_SCHED __builtin_amdgcn_sched_barrier(0)
    Unit cur, nxt; int ui = 0;
    if (!S.next(0, cur)) return;
    f32x4 acc[2][2][4][2];
#pragma unroll
    for (int a = 0; a < 2; ++a)
#pragma unroll
        for (int b = 0; b < 2; ++b)
#pragma unroll
            for (int m = 0; m < 4; ++m)
#pragma unroll
                for (int n = 0; n < 2; ++n) acc[a][b][m][n] = (f32x4){0.f, 0.f, 0.f, 0.f};
    bf16x8 At[4][2], B0[2][2], B1[2][2];
    const char* cA = (const char*)g.A + (size_t)cur.pm * tstep; const char* cB = (const char*)g.Bt + (size_t)cur.pn * tstep;
    S.a_ready(cur);
    if constexpr (SP2) {
        PG8_STAGE(PG8_SB(0, 0), cB, voffB); PG8_STAGE(PG8_SB(0, 1), cB + hstep, voffB); PG8_STAGE(PG8_SA(0, 0), cA, voffA); PG8_STAGE(PG8_SA(0, 1), cA + hstep, voffA);
        if (wr == 1) PG8_BAR;
        PG8_WAIT_V(2); PG8_BAR;
        PG8_STAGE(PG8_SB(1, 0), cB + kstep, voffB); PG8_STAGE(PG8_SA(1, 0), cA + kstep, voffA); PG8_STAGE(PG8_SB(1, 1), cB + hstep + kstep, voffB);
        PG8_WAIT_V(6); PG8_BAR;
    } else {
        PG8_STAGE(PG8_SB(0, 0), cB, voffB); PG8_STAGE(PG8_SA(0, 0), cA, voffA); PG8_STAGE(PG8_SB(0, 1), cB + hstep, voffB); PG8_STAGE(PG8_SA(0, 1), cA + hstep, voffA);
        if (wr == 1) PG8_BAR;
        PG8_WAIT_V(4); PG8_BAR;
        PG8_STAGE(PG8_SB(1, 0), cB + kstep, voffB); PG8_STAGE(PG8_SA(1, 0), cA + kstep, voffA); PG8_STAGE(PG8_SB(1, 1), cB + hstep + kstep, voffB);
        PG8_WAIT_V(6); PG8_BAR;
    }
    for (;;) {
        const bool has_next = S.next(ui + 1, nxt);
        const char* nA = has_next ? (const char*)g.A + (size_t)nxt.pm * tstep : cA; const char* nB = has_next ? (const char*)g.Bt + (size_t)nxt.pn * tstep : cB;
        for (int t = 0; t < nt; t += 2) {
            const bool last = (t == nt - 2);
            const char* a1 = cA + (size_t)(t + 1) * kstep;
            const char* a2 = last ? nA : cA + (size_t)(t + 2) * kstep; const char* b2 = last ? nB : cB + (size_t)(t + 2) * kstep;
            const char* a3 = a2 + kstep; const char* b3 = b2 + kstep;
            if (last && has_next) S.a_ready(nxt);
            if constexpr (SP2) {
            PG8_LDB(B0, 0, 0); PG8_LDB(B1, 0, 1); PG8_SCHED; PG8_LDA(At, 0, 0); PG8_STAGE(PG8_SA(1, 1), a1 + hstep, voffA);
            PG8_WAIT_V(8); PG8_WAIT_L(0); PG8_BAR; PG8_MMA(0, 0, At, B0); PG8_MMA(0, 1, At, B1); PG8_BAR; PG8_SCHED;
            PG8_LDA(At, 0, 1); PG8_STAGE(PG8_SB(0, 0), b2, voffB); PG8_STAGE(PG8_SB(0, 1), b2 + hstep, voffB); PG8_STAGE(PG8_SA(0, 0), a2, voffA);
            PG8_WAIT_V(8); PG8_WAIT_L(0); PG8_BAR; PG8_MMA(1, 0, At, B0); PG8_MMA(1, 1, At, B1); PG8_BAR; PG8_SCHED;
            PG8_LDB(B0, 1, 0); PG8_LDB(B1, 1, 1); PG8_SCHED; PG8_LDA(At, 1, 0); PG8_STAGE(PG8_SA(0, 1), a2 + hstep, voffA);
            PG8_WAIT_V(8); PG8_WAIT_L(0); PG8_BAR; PG8_MMA(0, 0, At, B0); PG8_MMA(0, 1, At, B1); PG8_BAR; PG8_SCHED;
            PG8_LDA(At, 1, 1); PG8_STAGE(PG8_SB(1, 0), b3, voffB); PG8_STAGE(PG8_SB(1, 1), b3 + hstep, voffB); PG8_STAGE(PG8_SA(1, 0), a3, voffA);
            PG8_WAIT_V(8); PG8_WAIT_L(0); PG8_BAR; PG8_MMA(1, 0, At, B0); PG8_MMA(1, 1, At, B1); PG8_BAR; PG8_SCHED;
            } else {
            PG8_LDB(B0, 0, 0); PG8_SCHED; PG8_LDA(At, 0, 0); PG8_STAGE(PG8_SA(1, 1), a1 + hstep, voffA);
            PG8_WAIT_L(8); PG8_BAR; PG8_WAIT_L(0); PG8_MMA(0, 0, At, B0); PG8_BAR; PG8_SCHED;
            PG8_LDB(B1, 0, 1); PG8_STAGE(PG8_SB(0, 0), b2, voffB);
            PG8_BAR; PG8_WAIT_L(0); PG8_MMA(0, 1, At, B1); PG8_BAR;
            PG8_LDA(At, 0, 1); PG8_STAGE(PG8_SA(0, 0), a2, voffA);
            PG8_BAR; PG8_WAIT_L(0); PG8_MMA(1, 0, At, B0); PG8_BAR; PG8_SCHED;
            PG8_STAGE(PG8_SB(0, 1), b2 + hstep, voffB);
            PG8_WAIT_V(6); PG8_BAR; PG8_MMA(1, 1, At, B1); PG8_BAR;
            PG8_LDB(B0, 1, 0); PG8_SCHED; PG8_LDA(At, 1, 0); PG8_STAGE(PG8_SA(0, 1), a2 + hstep, voffA);
            PG8_WAIT_L(8); PG8_BAR; PG8_WAIT_L(0); PG8_MMA(0, 0, At, B0); PG8_BAR; PG8_SCHED;
            PG8_LDB(B1, 1, 1); PG8_STAGE(PG8_SB(1, 0), b3, voffB);
            PG8_BAR; PG8_WAIT_L(0); PG8_MMA(0, 1, At, B1); PG8_BAR;
            PG8_LDA(At, 1, 1); PG8_STAGE(PG8_SA(1, 0), a3, voffA);
            PG8_BAR; PG8_WAIT_L(0); PG8_MMA(1, 0, At, B0); PG8_BAR; PG8_SCHED;
            PG8_STAGE(PG8_SB(1, 1), b3 + hstep, voffB);
            PG8_WAIT_V(6); PG8_BAR; PG8_MMA(1, 1, At, B1); PG8_BAR;
            }
        }
        if constexpr (ALIGN_EPI) { if (wr == 0) PG8_BAR; }
        if constexpr (!Epi::AFTER_DRAIN) { E(acc, cur, ui, wr, wc, fr, fq); S.done(cur); }
        if (!has_next) break;
#pragma unroll
        for (int a = 0; a < 2; ++a)
#pragma unroll
            for (int b = 0; b < 2; ++b)
#pragma unroll
                for (int m = 0; m < 4; ++m)
#pragma unroll
                    for (int n = 0; n < 2; ++n) acc[a][b][m][n] = (f32x4){0.f, 0.f, 0.f, 0.f};
        cur = nxt; cA = nA; cB = nB; ++ui;
        if constexpr (ALIGN_EPI) { if (wr == 1) PG8_BAR; }
    }
    PG8_WAIT_V(0);
    if constexpr (!ALIGN_EPI) { if (wr == 0) PG8_BAR; }
    PG8_BAR;
    if constexpr (Epi::AFTER_DRAIN) { E.fused(acc, cur, wr, wc, fr, fq, lds, wid, lane); S.done(cur); }
#undef PG8_SA
#undef PG8_SB
#undef PG8_STAGE
#undef PG8_LDA
#undef PG8_LDB
#undef PG8_MMA
#undef PG8_WAIT_V
#undef PG8_WAIT_L
#undef PG8_BAR
#undef PG8_SCHED
}
}

__device__ __forceinline__ void rope4(f32x4& v, const f32x4 cs  ) {
  const float a0 = v.x * cs.x - v.y * cs.y, b0 = v.x * cs.y + v.y * cs.x, a1 = v.z * cs.z - v.w * cs.w, b1 = v.z * cs.w + v.w * cs.z;
  v = (f32x4){a0, b0, a1, b1};
}
__device__ __forceinline__ f32x4 silu4(f32x4 x) { const f32x4 t = x * (-1.4426950408889634f);
  const f32x4 d = (f32x4){__builtin_amdgcn_exp2f(t.x), __builtin_amdgcn_exp2f(t.y), __builtin_amdgcn_exp2f(t.z), __builtin_amdgcn_exp2f(t.w)} + 1.f;
  return x * (f32x4){__builtin_amdgcn_rcpf(d.x), __builtin_amdgcn_rcpf(d.y), __builtin_amdgcn_rcpf(d.z), __builtin_amdgcn_rcpf(d.w)}; }
__device__ __forceinline__ float logsig(float x) { return fminf(x, 0.f) - __logf(1.f + __expf(-fabsf(x))); }
struct EpiIn {
  const Params& P; int layer; const float* lrstd; const float* ltab; const float* lbias; const float* lqkn;
  static constexpr bool PERM = true, AFTER_DRAIN = false;
  __device__ __forceinline__ void operator()(const f32x4 (&acc)[2][2][4][2], const pg8::Unit& u, int ui, int wr, int wc, int fr, int fq) const { (*this)(acc, u.pm, u.pn, ui, wr, wc, fr, fq); }
  template <int KIND>
  __device__ __forceinline__ void rows(const f32x4 (&acc)[2][2][4][2], int pm, int pn, int ui, int wr, int wc, int fr, int fq) const {
    asm volatile("" : "+v"(fr), "+v"(fq));
    const bool lat = pm < 128; const int bb = lat ? (pm >> 3) : 16;
    const float* bias = lbias + ui * 256; (void)bb;
    const int cw = 32 * wc + 8 * fq;
    f32x4 bv[2][2];
#pragma unroll
    for (int bj = 0; bj < 2; ++bj)
#pragma unroll
      for (int n = 0; n < 2; ++n) bv[bj][n] = *(const f32x4*)(bias + 128 * bj + cw + 4 * n);
    const bool isnorm = KIND == 1 && ((pn == 4) || (wc < 2));
    const float* gsrc = lqkn + (pn == 4 ? 0 : 64);
    float rsv[2][4];
#pragma unroll
    for (int ai = 0; ai < 2; ++ai)
#pragma unroll
      for (int m = 0; m < 4; ++m) rsv[ai][m] = lrstd[ui * 256 + 128 * ai + 64 * wr + 16 * m + fr];
#pragma unroll
    for (int ai = 0; ai < 2; ++ai)
#pragma unroll
      for (int m = 0; m < 4; ++m) {
        const int row = pm * 256 + 128 * ai + 64 * wr + 16 * m + fr;
        const float rstd = rsv[ai][m];
        f32x4 v[2][2];
#pragma unroll
        for (int bj = 0; bj < 2; ++bj)
#pragma unroll
          for (int n = 0; n < 2; ++n) v[bj][n] = acc[ai][bj][m][n] * rstd + bv[bj][n];
        const int t = row & 2047;
        bf16_t* prow = ((bf16_t*)(P.ws + WS_PROJ)) + (size_t)row * NPROJ;
        if (KIND == 0) {
          if (lat) { const int pos = (fq >> 1) == 0 ? (t >> 6) : (t & 63);
#pragma unroll
            for (int bj = 0; bj < 2; ++bj)
#pragma unroll
              for (int n = 0; n < 2; ++n) { const int j = 4 * (fq & 1) + 2 * n; const float* tc = ltab + T_COSA + pos * 8 + j; const float* ts = ltab + T_SINA + pos * 8 + j;
                rope4(v[bj][n], (f32x4){tc[0], ts[0], tc[1], ts[1]}); } }
          const float sc = pn == 0 ? 0.17677669529663687f * LOG2E : 1.f;
#pragma unroll
          for (int bj = 0; bj < 2; ++bj) { const f32x4 a = v[bj][0] * sc, b = v[bj][1] * sc;
            *(u32x4*)(prow + pn * 256 + 128 * bj + cw) = (u32x4){pk2(a.x, a.y), pk2(a.z, a.w), pk2(b.x, b.y), pk2(b.z, b.w)}; }
        } else if (KIND == 1) {
          if (isnorm) {
            float hs = 0.f;
#pragma unroll
            for (int bj = 0; bj < 2; ++bj)
#pragma unroll
              for (int n = 0; n < 2; ++n) hs += (v[bj][n].x * v[bj][n].x + v[bj][n].y * v[bj][n].y) + (v[bj][n].z * v[bj][n].z + v[bj][n].w * v[bj][n].w);
            hs += __shfl_xor(hs, 16); hs += __shfl_xor(hs, 32);
            const float hr = rsqrtf(hs * (1.f / 64.f) + EPS);
#pragma unroll
            for (int bj = 0; bj < 2; ++bj)
#pragma unroll
              for (int n = 0; n < 2; ++n) { const int j0 = bj * 32 + 4 * fq + 2 * n; v[bj][n] = v[bj][n] * hr * (f32x4){gsrc[j0], gsrc[j0 + 16], gsrc[j0 + 1], gsrc[j0 + 17]}; }
            if (lat) {
#pragma unroll
              for (int bj = 0; bj < 2; ++bj) { const int pos = bj == 0 ? (t >> 6) : (t & 63);
#pragma unroll
                for (int n = 0; n < 2; ++n) { const int j = 4 * fq + 2 * n; const float* tc = ltab + T_COSB + pos * 16 + j; const float* ts = ltab + T_SINB + pos * 16 + j;
                  rope4(v[bj][n], (f32x4){tc[0], ts[0], tc[1], ts[1]}); } } }
          }
          const float sc = pn == 4 ? 0.125f * LOG2E : 1.f;
          const int dbase = pn == 4 ? C_BQ + wc * 64 : (wc < 2 ? C_BK + wc * 64 : C_BV + (wc - 2) * 64);
#pragma unroll
          for (int bj = 0; bj < 2; ++bj) { const f32x4 a = v[bj][0] * sc, b = v[bj][1] * sc;
            *(u32x4*)(prow + dbase + bj * 32 + 8 * fq) = (u32x4){pk2(a.x, a.y), pk2(a.z, a.w), pk2(b.x, b.y), pk2(b.z, b.w)}; }
        } else if (KIND == 2) {
#pragma unroll
          for (int bj = 0; bj < 2; ++bj) { float* grow = ((float*)(P.ws + WS_GATE)) + (((size_t)((row >> 6) * 4 + wc) * 2 + bj) * 64 + (row & 63)) * 32 + 8 * fq;
#pragma unroll
            for (int n = 0; n < 2; ++n) { const f32x4 x = v[bj][n];
              *(f32x4*)(grow + 4 * n) = (f32x4){logsig(x.x) * 0.0625f, logsig(x.y) * 0.0625f, logsig(x.z) * 0.0625f, logsig(x.w) * 0.0625f}; } }
        } else {
#pragma unroll
          for (int bj = 0; bj < 2; ++bj) { f32x4 a = v[bj][0], b = v[bj][1];
            if (KIND == 4) { a = silu4(a); b = silu4(b); }
            if (KIND == 5 && bj == 0) { a = a * 0.17677669529663687f; b = b * 0.17677669529663687f; }
            *(u32x4*)(prow + pn * 256 + 128 * bj + cw) = (u32x4){pk2(a.x, a.y), pk2(a.z, a.w), pk2(b.x, b.y), pk2(b.z, b.w)}; }
        }
      }
  }
  __device__ __forceinline__ void operator()(const f32x4 (&acc)[2][2][4][2], int pm, int pn, int ui, int wr, int wc, int fr, int fq) const {
    if (pn <= 1) rows<0>(acc, pm, pn, ui, wr, wc, fr, fq);
    else if (pn == 4 || pn == 5) rows<1>(acc, pm, pn, ui, wr, wc, fr, fq);
    else if (pn == 13) rows<2>(acc, pm, pn, ui, wr, wc, fr, fq);
    else if (pn == 3 || pn == 6 || pn == 9 || pn == 12) rows<4>(acc, pm, pn, ui, wr, wc, fr, fq);
    else if (pn == 10) rows<5>(acc, pm, pn, ui, wr, wc, fr, fq);
    else rows<3>(acc, pm, pn, ui, wr, wc, fr, fq);
  }
};
template <bool F32IN, bool F32OUT> struct EpiOut {
  const Params& P; int layer;
  static constexpr bool PERM = true, AFTER_DRAIN = false;
  __device__ __forceinline__ void operator()(const f32x4 (&acc)[2][2][4][2], const pg8::Unit& u, int ui, int wr, int wc, int fr, int fq) const { (*this)(acc, u.pm, u.pn, wr, wc, fr, fq); }
  __device__ __forceinline__ void operator()(const f32x4 (&acc)[2][2][4][2], int pm, int pn, int wr, int wc, int fr, int fq) const {
    asm volatile("" : "+v"(fr), "+v"(fq));
    const bool lat = pm < 128; const int bb = lat ? (pm >> 3) : 16;
    constexpr bool hn = !F32OUT;
    const float* gate = ((float*)(P.ws + WS_MOD)) + (size_t)(layer * 17 + bb) * 3072 + 2048 + pn * 256;
    const float* ng = PVEC(P) + PV_NORMG + (hn ? layer + 1 : layer) * DM + pn * 256;
    const float* nsc = ((float*)(P.ws + WS_MOD)) + (size_t)((hn ? layer + 1 : layer) * 17 + bb) * 3072 + 1024 + pn * 256;
    const int cw = 32 * wc + 8 * fq;
    f32x4 gv[2][2], cf[2][2];
#pragma unroll
    for (int bj = 0; bj < 2; ++bj)
#pragma unroll
      for (int n = 0; n < 2; ++n) { const int c0 = 128 * bj + cw + 4 * n; gv[bj][n] = *(const f32x4*)(gate + c0); if (hn) cf[bj][n] = *(const f32x4*)(ng + c0) * (*(const f32x4*)(nsc + c0) + 1.f); }
    const bf16_t* rb = lat ? (const bf16_t*)P.out + (size_t)(layer & 1) * NLAT * DM : (const bf16_t*)(P.ws + WS_XC) + (size_t)(layer & 1) * NCTX * DM;
    bf16_t* wb = lat ? (bf16_t*)P.out + (size_t)((layer + 1) & 1) * NLAT * DM : (bf16_t*)(P.ws + WS_XC) + (size_t)((layer + 1) & 1) * NCTX * DM;
    constexpr int RB = F32IN ? 2 : 4;
#pragma unroll
    for (int am = 0; am < 8 / RB; ++am) { const int ai = (am * RB) >> 2, mb = (am * RB) & 3;
      f32x4 xf[F32IN ? RB : 1][2][2]; u32x4 xh[F32IN ? 1 : RB][2];
#pragma unroll
      for (int mm = 0; mm < RB; ++mm) { const int row = pm * 256 + 128 * ai + 64 * wr + 16 * (mb + mm) + fr; const size_t rl = lat ? (size_t)row : (size_t)(row - NLAT);
        if (F32IN) { const float* xo = lat ? P.x + rl * DM : P.ctx + rl * DM;
#pragma unroll
          for (int bj = 0; bj < 2; ++bj)
#pragma unroll
            for (int n = 0; n < 2; ++n) xf[mm][bj][n] = __builtin_nontemporal_load((const f32x4*)(xo + pn * 256 + 128 * bj + cw + 4 * n)); }
        else {
#pragma unroll
          for (int bj = 0; bj < 2; ++bj) xh[mm][bj] = __builtin_nontemporal_load((const u32x4*)(rb + rl * DM + pn * 256 + 128 * bj + cw)); } }
#pragma unroll
      for (int mm = 0; mm < RB; ++mm) {
        const int m = mb + mm; const int row = pm * 256 + 128 * ai + 64 * wr + 16 * m + fr; const size_t rl = lat ? (size_t)row : (size_t)(row - NLAT);
        float ssq = 0.f;
#pragma unroll
        for (int bj = 0; bj < 2; ++bj) { f32x4 xn[2];
          if (F32IN) { xn[0] = xf[mm][bj][0]; xn[1] = xf[mm][bj][1]; }
          else { const u32x4 w = xh[mm][bj]; xn[0] = (f32x4){bflo(w.x), bfhi(w.x), bflo(w.y), bfhi(w.y)}; xn[1] = (f32x4){bflo(w.z), bfhi(w.z), bflo(w.w), bfhi(w.w)}; }
#pragma unroll
          for (int n = 0; n < 2; ++n) { xn[n] = xn[n] + gv[bj][n] * acc[ai][bj][m][n]; ssq += (xn[n].x * xn[n].x + xn[n].y * xn[n].y) + (xn[n].z * xn[n].z + xn[n].w * xn[n].w); }
          const int c = pn * 256 + 128 * bj + cw;
          if (F32OUT) { *(u32x4*)(((bf16_t*)(P.ws + WS_PROJ)) + (rl >> 12) * ((size_t)4096 * NPROJ) + (rl & 4095) * DM + c) = (u32x4){pk2(xn[0].x, xn[0].y), pk2(xn[0].z, xn[0].w), pk2(xn[1].x, xn[1].y), pk2(xn[1].z, xn[1].w)}; }
          else { *(u32x4*)(wb + rl * DM + c) = (u32x4){pk2(xn[0].x, xn[0].y), pk2(xn[0].z, xn[0].w), pk2(xn[1].x, xn[1].y), pk2(xn[1].z, xn[1].w)};
            const f32x4 a = xn[0] * cf[bj][0], b = xn[1] * cf[bj][1];
            *(u32x4*)(((bf16_t*)(P.ws + WS_XS)) + (size_t)row * DM + c) = (u32x4){pk2(a.x, a.y), pk2(a.z, a.w), pk2(b.x, b.y), pk2(b.z, b.w)}; } }
        ssq += __shfl_xor(ssq, 16); ssq += __shfl_xor(ssq, 32);
        if (fq == 0) ((float*)(P.ws + WS_SSP))[(size_t)(pn * 4 + wc) * MROWS + row] = ssq;
      }
      asm volatile("" ::: "memory");
    }
  }
};

__device__ __forceinline__ void final_norm(const Params& P) {
  const int tid = tid_now(), lane = tid & 63, wave = tid >> 6;
  const bool aff = gridDim.x == 256;
  const int gw = aff ? (int)(blockIdx.x >> 3) * 8 + wave : (int)blockIdx.x * 8 + wave, NGW = aff ? 256 : (int)gridDim.x * 8;
  const int rbeg = aff ? (int)(blockIdx.x & 7) * 4096 : 0, rend = aff ? rbeg + 4096 : NLAT;
  f32x4 g[4];
#pragma unroll
  for (int j = 0; j < 4; ++j) g[j] = *(const f32x4*)(P.final_g + 4 * (lane + 64 * j));
  for (int row0 = rbeg + gw * 4; row0 < rend; row0 += NGW * 4) {
    u32x2 v[4][4]; float ss[4];
#pragma unroll
    for (int r = 0; r < 4; ++r) { ss[r] = lane < 16 ? ((float*)(P.ws + WS_SSP))[(size_t)lane * MROWS + row0 + r] : 0.f;
#pragma unroll
      for (int j = 0; j < 4; ++j) v[r][j] = __builtin_nontemporal_load((const u32x2*)(((const bf16_t*)(P.ws + WS_PROJ)) + (size_t)((row0 + r) >> 12) * ((size_t)4096 * NPROJ) + (size_t)((row0 + r) & 4095) * DM + 4 * (lane + 64 * j))); }
#pragma unroll
    for (int r = 0; r < 4; ++r) { const float rstd = rsqrtf(wave_sum(ss[r]) * (1.f / DM) + EPS);
#pragma unroll
      for (int j = 0; j < 4; ++j) { const f32x4 x = {bflo(v[r][j].x), bfhi(v[r][j].x), bflo(v[r][j].y), bfhi(v[r][j].y)}; __builtin_nontemporal_store(x * rstd * g[j], (f32x4*)(P.out + (size_t)(row0 + r) * DM + 4 * (lane + 64 * j))); } }
  }
}
namespace att {
using bf16x8=__attribute__((ext_vector_type(8)))short;
using s16x4=__attribute__((ext_vector_type(4)))short;
using f32x16=__attribute__((ext_vector_type(16)))float;
constexpr int NW=8,QBLK=32,QB=QBLK*NW,KVBLK=64,PITCH=NPROJ;
__device__ __forceinline__ int crow(int r,int hi){return (r&3)+8*(r>>2)+4*hi;}
#define SBAR() __builtin_amdgcn_sched_barrier(0)
constexpr int NSLOT=3, SLOTB=8192;
constexpr int LDS_K=0, LDS_V=NSLOT*SLOTB, LDS_WS=2*NSLOT*SLOTB, LDS_OST=LDS_WS+NW*64*4, LDS_BYTES_ATT=LDS_OST+NW*8192;
__device__ __forceinline__ void glds16(const void*gsrc,unsigned lds_dst){unsigned keep;
  asm volatile("s_mov_b32 %0, m0\n\ts_mov_b32 m0, %2\n\ts_nop 0\n\tglobal_load_lds_dwordx4 %1, off\n\ts_mov_b32 m0, %0":"=&s"(keep):"v"(gsrc),"s"(lds_dst):"memory");}
__device__ __forceinline__ float max3f(float a,float b,float c){float r;asm("v_max3_f32 %0, %1, %2, %3":"=v"(r):"v"(a),"v"(b),"v"(c));return r;}
__device__ __forceinline__ float max2f(float a,float b){float r;asm("v_max_f32_e32 %0, %1, %2":"=v"(r):"v"(a),"v"(b));return r;}
__device__ __forceinline__ float fadd_s(float a,float b){float r;asm("v_add_f32_e32 %0, %1, %2":"=v"(r):"v"(a),"v"(b));return r;}
__device__ __forceinline__ float fsub_s(float a,float b){float r;asm("v_sub_f32_e32 %0, %1, %2":"=v"(r):"v"(a),"v"(b));return r;}
typedef float f32x2_t __attribute__((ext_vector_type(2))); typedef __bf16 bf16x2_t __attribute__((ext_vector_type(2)));
__device__ __forceinline__ unsigned cvtpk_s(float lo,float hi){f32x2_t v={lo,hi};bf16x2_t b=__builtin_convertvector(v,bf16x2_t);return __builtin_bit_cast(unsigned,b);}
#define WAIT_BAR(N) asm volatile("s_waitcnt vmcnt(" #N ") lgkmcnt(0)\n\ts_barrier":::"memory")
template<int ND> __device__ __forceinline__ void qkt(f32x16&p0,f32x16&p1,const char*Kslot,const bf16x8*qr,const f32x16&negm,int r32,int hi){
  const char*kb=Kslot+hi*1024+r32*16;
  #pragma unroll
  for(int d0=0;d0<ND;++d0){
    const bf16x8 b0=*reinterpret_cast<const bf16x8*>(kb+d0*2048);
    const bf16x8 b1=*reinterpret_cast<const bf16x8*>(kb+d0*2048+512);
    if(d0==0){p0=__builtin_amdgcn_mfma_f32_32x32x16_bf16(b0,qr[0],negm,0,0,0);p1=__builtin_amdgcn_mfma_f32_32x32x16_bf16(b1,qr[0],negm,0,0,0);}
    else{p0=__builtin_amdgcn_mfma_f32_32x32x16_bf16(b0,qr[d0],p0,0,0,0);p1=__builtin_amdgcn_mfma_f32_32x32x16_bf16(b1,qr[d0],p1,0,0,0);}}
}
typedef __attribute__((address_space(3))) const char* lds_cptr;
typedef short v4i16_t __attribute__((ext_vector_type(4)));
__device__ __forceinline__ void kload8(bf16x8*kf,lds_cptr kp){
  kf[0]=*(const __attribute__((address_space(3))) bf16x8*)(kp);      kf[1]=*(const __attribute__((address_space(3))) bf16x8*)(kp+512);
  kf[2]=*(const __attribute__((address_space(3))) bf16x8*)(kp+2048); kf[3]=*(const __attribute__((address_space(3))) bf16x8*)(kp+2560);
  kf[4]=*(const __attribute__((address_space(3))) bf16x8*)(kp+4096); kf[5]=*(const __attribute__((address_space(3))) bf16x8*)(kp+4608);
  kf[6]=*(const __attribute__((address_space(3))) bf16x8*)(kp+6144); kf[7]=*(const __attribute__((address_space(3))) bf16x8*)(kp+6656);
}
__device__ __forceinline__ void kload2(bf16x8*kf,lds_cptr kp,int j){ kf[2*j]=*(const __attribute__((address_space(3))) bf16x8*)(kp+j*2048); kf[2*j+1]=*(const __attribute__((address_space(3))) bf16x8*)(kp+j*2048+512); }
__device__ __forceinline__ s16x4 vtr(lds_cptr p){ return __builtin_bit_cast(s16x4,__builtin_amdgcn_ds_read_tr16_b64_v4i16((__attribute__((address_space(3))) v4i16_t*)p)); }
__device__ __forceinline__ float rowmax(const f32x16&p0,const f32x16&p1){
  float a=max3f(p0[0],p0[1],p1[0]),b=max3f(p0[2],p0[3],p1[1]);a=max3f(a,p1[2],p1[3]);
  #pragma unroll
  for(int r=4;r<16;r+=4){a=max3f(a,p0[r],p0[r+1]);b=max3f(b,p0[r+2],p0[r+3]);a=max3f(a,p1[r],p1[r+1]);b=max3f(b,p1[r+2],p1[r+3]);}
  const float m=max2f(a,b);
  auto rr=__builtin_amdgcn_permlane32_swap(__float_as_uint(m),__float_as_uint(m),false,false);
  return max2f(__uint_as_float(rr[0]),__uint_as_float(rr[1]));
}
__device__ __forceinline__ void pv(f32x16*o,int vb,bf16x8 pa0,bf16x8 pa1,bf16x8 pa2,bf16x8 pa3){
  #pragma unroll
  for(int d0=0;d0<2;++d0){s16x4 lo[4],hi[4];
    #pragma unroll
    for(int ks=0;ks<4;++ks){
      asm volatile("ds_read_b64_tr_b16 %0,%1 offset:%c2":"=&v"(lo[ks]):"v"(vb),"i"(d0*4096+ks*1024):"memory");
      asm volatile("ds_read_b64_tr_b16 %0,%1 offset:%c2":"=&v"(hi[ks]):"v"(vb),"i"(d0*4096+ks*1024+512):"memory");}
    asm volatile("s_waitcnt lgkmcnt(0)":::"memory");SBAR();
    #define PK(k) (bf16x8){lo[k][0],lo[k][1],lo[k][2],lo[k][3],hi[k][0],hi[k][1],hi[k][2],hi[k][3]}
    o[d0]=__builtin_amdgcn_mfma_f32_32x32x16_bf16(pa0,PK(0),o[d0],0,0,0);
    o[d0]=__builtin_amdgcn_mfma_f32_32x32x16_bf16(pa1,PK(1),o[d0],0,0,0);
    o[d0]=__builtin_amdgcn_mfma_f32_32x32x16_bf16(pa2,PK(2),o[d0],0,0,0);
    o[d0]=__builtin_amdgcn_mfma_f32_32x32x16_bf16(pa3,PK(3),o[d0],0,0,0);
    #undef PK
  }
}
template<int TYPE,int THRL> __device__ __forceinline__ void attn_unit(const Params&P,int layer,int b,int h,int qb,char*shm,bool pre=false,int nxt=-1){
  const int tid=tid_now(),lane=tid&63,r32=lane&31,hi=lane>>5; const int wid=__builtin_amdgcn_readfirstlane(tid>>6);
  const bool isctx=(qb==8);
  const int crow0=NLAT+b*CTXL, lrow0=b*SEQ;
  const int q0=isctx?crow0:lrow0+qb*QB;
  const int NT=isctx?4:36;
  const int qcol=TYPE==0?C_AQ+h*64:C_BQ+h*64, kcol=TYPE==0?C_AK+h*64:C_BK+(h>>1)*64, vcol=TYPE==0?C_AV+h*64:C_BV+(h>>1)*64;
  const bf16_t*Qw=((bf16_t*)(P.ws + WS_PROJ))+(size_t)(q0+wid*QBLK)*PITCH+qcol;
  const unsigned lds0=(unsigned)(uintptr_t)shm;
  float*wsf=(float*)(shm+LDS_WS)+wid*64;
  const bf16_t*ksrc=((bf16_t*)(P.ws + WS_PROJ))+(long)lane*PITCH+kcol+wid*8;
  const bf16_t*vsrc=((bf16_t*)(P.ws + WS_PROJ))+(long)(16*(wid&3)+(lane>>2))*PITCH+vcol+(wid>>2)*32+(lane&3)*8;
  const unsigned kdst=lds0+LDS_K+wid*1024, vdst=lds0+LDS_V+wid*1024;
  #define TROW(t) ((long)((t)<4?crow0+(t)*KVBLK:lrow0+((t)-4)*KVBLK)*PITCH)
  #define DMA_K(t,slot) glds16(ksrc+TROW(t),(unsigned)__builtin_amdgcn_readfirstlane(kdst+(slot)))
  #define DMA_V(t,slot) glds16(vsrc+TROW(t),(unsigned)__builtin_amdgcn_readfirstlane(vdst+(slot)))
  const int vb0=(int)(lds0+LDS_V)+((lane>>4)&1)*32+(lane&3)*8+(4*hi+((lane&15)>>2))*64;
  const char*Kbase=shm+LDS_K; bf16x8 kf[8];
  const lds_cptr shm3=(lds_cptr)shm; const lds_cptr kp0=shm3+LDS_K+hi*1024+r32*16; const lds_cptr vp0=shm3+LDS_V+((lane>>4)&1)*32+(lane&3)*8+(4*hi+((lane&15)>>2))*64;
  float*stgf=(float*)(shm+LDS_OST)+wid*2048;
  for(int pass=0;pass<(TYPE==0?2:1);++pass){
  if(!(pre&&pass==0)&&!(TYPE==0&&pass==1)){DMA_K(0,0);DMA_V(0,0);DMA_K(1,SLOTB);}
  bf16x8 qr[4];
  #pragma unroll
  for(int d0=0;d0<(TYPE==0?2:4);++d0)qr[d0]=*reinterpret_cast<const bf16x8*>(&Qw[(long)r32*PITCH+((TYPE==0?2*pass:0)+d0)*16+hi*8]);
  if(TYPE==0){qr[2]=qr[0];qr[3]=qr[1];}
  const int koff=TYPE==0?pass*4096:0; const lds_cptr kpp=kp0+koff;
  float mhat=0.f,l_reg=0.f;f32x16 o[2];o[0]=f32x16{};o[1]=f32x16{};f32x16 negm=f32x16{};asm volatile("":"+v"(negm));
  bool resc=false;
  #define START(P0,P1) do{ const float rm=rowmax(P0,P1); resc=false; \
    { const float dl=rm; mhat=fadd_s(mhat,dl); \
      _Pragma("unroll") for(int r=0;r<16;++r){P0[r]=fsub_s(P0[r],dl);P1[r]=fsub_s(P1[r],dl);} \
      _Pragma("unroll") for(int r=0;r<16;++r)negm[r]=-mhat; asm volatile("":"+v"(negm)); } \
    _Pragma("unroll") for(int r=0;r<16;++r)P0[r]=__builtin_amdgcn_exp2f(P0[r]); }while(0)
  #define RESC() do{ if(resc){ asm volatile("s_waitcnt lgkmcnt(0)":::"memory"); \
      _Pragma("unroll") for(int d_=0;d_<2;++d_) _Pragma("unroll") for(int r=0;r<16;++r)o[d_][r]*=wsf[crow(r,hi)]; } }while(0)
  f32x16 pA0,pA1,pB0,pB1;
  int sl_prev=0,sl_cur=0,sl_next=SLOTB;
  #define ROT() do{sl_prev=sl_cur;sl_cur=sl_next;sl_next=(sl_next==(NSLOT-1)*SLOTB)?0:sl_next+SLOTB;}while(0)
  DMA_K(2,2*SLOTB);
  WAIT_BAR(3);
  qkt<(TYPE==0?2:4)>(pA0,pA1,Kbase+koff,qr,negm,r32,hi);asm volatile("s_nop 15\n\ts_nop 7":"+v"(pA0),"+v"(pA1));
  START(pA0,pA1);
  _Pragma("unroll") for(int r=0;r<16;++r)pA1[r]=__builtin_amdgcn_exp2f(pA1[r]);
  WAIT_BAR(0);
  DMA_K(3,0);DMA_V(1,SLOTB);
  ROT();
  if(TYPE==0){kload2(kf,kpp+sl_cur,0);kload2(kf,kpp+sl_cur,1);}else kload8(kf,kp0+sl_cur);
  WAIT_BAR(2);
  s16x4 vlo[8],vhi[8]; u32x4 pw0,pw1,pw2,pw3;
  #define PKW(P,B) cvtpk_s(P[B],P[B+1])
  #define PAF(k) __builtin_bit_cast(bf16x8,pw##k)
  #define VFR(i) (bf16x8){vlo[i][0],vlo[i][1],vlo[i][2],vlo[i][3],vhi[i][0],vhi[i][1],vhi[i][2],vhi[i][3]}
  #define PIN(x) asm volatile("":"+v"(x))
  #define MX3(a,b,c) __builtin_fmaxf(__builtin_fmaxf((a),(b)),(c))
  #define GAPA(MF,A0,A1,A2,A3,W0,W1,PW) do{ MF; sacc+=A0; sacc+=A1; sacc+=A2; sacc+=A3; PIN(sacc); W0; W1; PIN(PW); SBAR(); }while(0)
  #define EX(v) __builtin_amdgcn_exp2f(v)
  #define GAPB(MF,X,B) do{ MF; X[B]=EX(X[B]); X[B+1]=EX(X[B+1]); X[B+2]=EX(X[B+2]); X[B+3]=EX(X[B+3]); PIN(X); SBAR(); }while(0)
  #define VRD(i) do{ vlo[i]=vtr(vp_+(((i)>>2)*4096+((i)&3)*1024)); vhi[i]=vtr(vp_+(((i)>>2)*4096+((i)&3)*1024+512)); }while(0)
  #define KRD(G,j) do{ if((G)&&(TYPE!=0||(j)<2)){ kload2(kf,kpp+sl_next,j); SBAR(); } }while(0)
  #define STEP(C0,C1,P0,P1,t,GK,GV,GL) do{ SBAR(); \
    const lds_cptr vp_=vp0+sl_prev; \
    VRD(0); SBAR(); float sacc=(P0[0]+P0[1]); \
    GAPA(C0=__builtin_amdgcn_mfma_f32_32x32x16_bf16(kf[0],qr[0],negm,0,0,0), P0[2],P0[3],P0[4],P0[5],     pw0[0]=PKW(P0,0), pw0[1]=PKW(P0,2), pw0); \
    VRD(4); SBAR(); GAPA(C1=__builtin_amdgcn_mfma_f32_32x32x16_bf16(kf[1],qr[0],negm,0,0,0), P0[6],P0[7],P0[8],P0[9],     pw0[2]=PKW(P0,4), pw0[3]=PKW(P0,6), pw0); \
    VRD(1); SBAR(); GAPA(C0=__builtin_amdgcn_mfma_f32_32x32x16_bf16(kf[2],qr[1],C0,0,0,0),   P0[10],P0[11],P0[12],P0[13], pw1[0]=PKW(P0,8), pw1[1]=PKW(P0,10), pw1); \
    VRD(5); SBAR(); GAPA(C1=__builtin_amdgcn_mfma_f32_32x32x16_bf16(kf[3],qr[1],C1,0,0,0),   P0[14],P0[15],P1[0],P1[1],   pw1[2]=PKW(P0,12),pw1[3]=PKW(P0,14), pw1); \
    VRD(2); SBAR(); GAPA(if(TYPE!=0)C0=__builtin_amdgcn_mfma_f32_32x32x16_bf16(kf[4],qr[2],C0,0,0,0),   P1[2],P1[3],P1[4],P1[5],     pw2[0]=PKW(P1,0), pw2[1]=PKW(P1,2), pw2); \
    VRD(6); SBAR(); GAPA(if(TYPE!=0)C1=__builtin_amdgcn_mfma_f32_32x32x16_bf16(kf[5],qr[2],C1,0,0,0),   P1[6],P1[7],P1[8],P1[9],     pw2[2]=PKW(P1,4), pw2[3]=PKW(P1,6), pw2); \
    VRD(3); SBAR(); GAPA(if(TYPE!=0)C0=__builtin_amdgcn_mfma_f32_32x32x16_bf16(kf[6],qr[3],C0,0,0,0),   P1[10],P1[11],P1[12],P1[13], pw3[0]=PKW(P1,8), pw3[1]=PKW(P1,10), pw3); \
    VRD(7); SBAR(); GAPA(if(TYPE!=0)C1=__builtin_amdgcn_mfma_f32_32x32x16_bf16(kf[7],qr[3],C1,0,0,0),   P1[14],P1[15],0.f,0.f,       pw3[2]=PKW(P1,12),pw3[3]=PKW(P1,14), pw3); \
    l_reg+=sacc; \
    if(GK){DMA_K((t)+3,sl_cur);} if(GV){DMA_V((t)+1,sl_next);} \
    { float a=MX3(C0[0],C0[1],C1[0]),b=MX3(C0[2],C0[3],C1[1]); a=MX3(a,C1[2],C1[3]); \
      _Pragma("unroll") for(int r=4;r<16;r+=4){a=MX3(a,C0[r],C0[r+1]);b=MX3(b,C0[r+2],C0[r+3]);a=MX3(a,C1[r],C1[r+1]);b=MX3(b,C1[r+2],C1[r+3]);} \
      float rm=__builtin_fmaxf(a,b); { auto rr=__builtin_amdgcn_permlane32_swap(__float_as_uint(rm),__float_as_uint(rm),false,false); rm=__builtin_fmaxf(__uint_as_float(rr[0]),__uint_as_float(rr[1])); } \
      resc=false; \
      if(__builtin_expect(__any(rm>(float)THRL),0)){ const float dl=__builtin_fmaxf(rm,0.f); mhat+=dl; \
        _Pragma("unroll") for(int r=0;r<16;++r){C0[r]-=dl;C1[r]-=dl;} \
        _Pragma("unroll") for(int r=0;r<16;++r)negm[r]=-mhat; asm volatile("":"+v"(negm)); \
        const float f=__builtin_amdgcn_exp2f(-dl); l_reg*=f; if(hi==0)wsf[r32]=f; resc=true; } } \
    SBAR(); \
    GAPB(o[0]=__builtin_amdgcn_mfma_f32_32x32x16_bf16(PAF(0),VFR(0),o[0],0,0,0), C0,0); \
    GAPB(o[1]=__builtin_amdgcn_mfma_f32_32x32x16_bf16(PAF(0),VFR(4),o[1],0,0,0), C0,4); \
    KRD(GL,0); GAPB(o[0]=__builtin_amdgcn_mfma_f32_32x32x16_bf16(PAF(1),VFR(1),o[0],0,0,0), C0,8); \
    KRD(GL,1); GAPB(o[1]=__builtin_amdgcn_mfma_f32_32x32x16_bf16(PAF(1),VFR(5),o[1],0,0,0), C0,12); \
    KRD(GL,2); GAPB(o[0]=__builtin_amdgcn_mfma_f32_32x32x16_bf16(PAF(2),VFR(2),o[0],0,0,0), C1,0); \
    KRD(GL,3); GAPB(o[1]=__builtin_amdgcn_mfma_f32_32x32x16_bf16(PAF(2),VFR(6),o[1],0,0,0), C1,4); \
    GAPB(o[0]=__builtin_amdgcn_mfma_f32_32x32x16_bf16(PAF(3),VFR(3),o[0],0,0,0), C1,8); \
    GAPB(o[1]=__builtin_amdgcn_mfma_f32_32x32x16_bf16(PAF(3),VFR(7),o[1],0,0,0), C1,12); \
    }while(0)
  int t=1;
  for(;t+5<NT;t+=2){
    STEP(pB0,pB1,pA0,pA1,t,true,true,true);     WAIT_BAR(2); RESC(); ROT();
    STEP(pA0,pA1,pB0,pB1,t+1,true,true,true);   WAIT_BAR(2); RESC(); ROT();
  }
  #define ENDW(tt) do{ if((tt)+3<NT){WAIT_BAR(2);} else if((tt)+2<NT){WAIT_BAR(1);} else {WAIT_BAR(0);} }while(0)
  for(;t+1<NT;t+=2){
    STEP(pB0,pB1,pA0,pA1,t,(t+3<NT),(t+1<NT),(t+1<NT));       ENDW(t);   RESC(); ROT();
    STEP(pA0,pA1,pB0,pB1,t+1,(t+4<NT),(t+2<NT),(t+2<NT));     ENDW(t+1); RESC(); ROT();
  }
  STEP(pB0,pB1,pA0,pA1,NT-1,false,false,false); RESC();
  { float sacc=pB0[0]+pB0[1]; _Pragma("unroll") for(int r=2;r<16;++r)sacc+=pB0[r]; _Pragma("unroll") for(int r=0;r<16;++r)sacc+=pB1[r]; l_reg+=sacc;
    pw0=(u32x4){PKW(pB0,0),PKW(pB0,2),PKW(pB0,4),PKW(pB0,6)};pw1=(u32x4){PKW(pB0,8),PKW(pB0,10),PKW(pB0,12),PKW(pB0,14)};pw2=(u32x4){PKW(pB1,0),PKW(pB1,2),PKW(pB1,4),PKW(pB1,6)};pw3=(u32x4){PKW(pB1,8),PKW(pB1,10),PKW(pB1,12),PKW(pB1,14)};
    SBAR(); pv(o,vb0+sl_cur,PAF(0),PAF(1),PAF(2),PAF(3)); }
  #undef PKW
  #undef PAF
  #undef VFR
  #undef PIN
  #undef MX3
  #undef GAPA
  #undef GAPB
  #undef EX
  #undef VRD
  #undef KRD
  #undef STEP
  #undef ENDW
  asm volatile("s_waitcnt lgkmcnt(0)\n\ts_barrier":::"memory");
  if(TYPE==0&&pass==0){DMA_K(0,0);DMA_V(0,0);DMA_K(1,SLOTB);}
  else if(nxt>=0){ const int nt_=nxt>>12,nb_=(nxt>>4)&15,nh_=nxt&3; const int nk_=nt_==0?C_AK+nh_*64:C_BK+(nh_>>1)*64, nv_=nt_==0?C_AV+nh_*64:C_BV+(nh_>>1)*64;
    const bf16_t*nks=((bf16_t*)(P.ws + WS_PROJ))+(long)lane*PITCH+nk_+wid*8+(long)(NLAT+nb_*CTXL)*PITCH;
    const bf16_t*nvs=((bf16_t*)(P.ws + WS_PROJ))+(long)(16*(wid&3)+(lane>>2))*PITCH+nv_+(wid>>2)*32+(lane&3)*8+(long)(NLAT+nb_*CTXL)*PITCH;
    glds16(nks,(unsigned)__builtin_amdgcn_readfirstlane(kdst)); glds16(nvs,(unsigned)__builtin_amdgcn_readfirstlane(vdst)); glds16(nks+(long)KVBLK*PITCH,(unsigned)__builtin_amdgcn_readfirstlane(kdst+SLOTB)); }
  {auto rr=__builtin_amdgcn_permlane32_swap(__float_as_uint(l_reg),__float_as_uint(l_reg),false,false);l_reg=__uint_as_float(rr[0])+__uint_as_float(rr[1]);}
  if(hi==0)wsf[32+r32]=l_reg;asm volatile("s_waitcnt lgkmcnt(0)":::"memory");
  float rli[16];
  #pragma unroll
  for(int r=0;r<16;++r)rli[r]=__builtin_amdgcn_rcpf(wsf[32+crow(r,hi)]);
  if(TYPE==0&&pass==0){
    #pragma unroll
    for(int d0=0;d0<2;++d0)
      #pragma unroll
      for(int r=0;r<16;++r)stgf[(d0*16+r)*64+lane]=o[d0][r]*rli[r];
    continue;
  }
  if(TYPE==0){ const float lam=((float*)(P.ws + WS_TAB))[T_LAM+layer];
    #pragma unroll
    for(int d0=0;d0<2;++d0)
      #pragma unroll
      for(int r=0;r<16;++r)o[d0][r]=stgf[(d0*16+r)*64+lane]-lam*(o[d0][r]*rli[r]);
    asm volatile("s_waitcnt lgkmcnt(0)":::"memory");
  } else {
    #pragma unroll
    for(int d0=0;d0<2;++d0)
      #pragma unroll
      for(int r=0;r<16;++r)o[d0][r]*=rli[r];
  }
  asm volatile("":"+v"(o[0]),"+v"(o[1])::"memory");
  #pragma unroll
  for(int r=0;r<16;++r){const int orow=crow(r,hi);
    #pragma unroll
    for(int d0=0;d0<2;++d0)stgf[orow*64+d0*32+r32]=o[d0][r];}
  asm volatile("s_waitcnt lgkmcnt(0)":::"memory");
  { const float post=TYPE==0?(1.f-((float*)(P.ws + WS_TAB))[T_LAMI+layer]):1.f; const float*sg=PVEC(P)+PV_SUBLN+layer*64;
    #pragma unroll
    for(int ih=0;ih<2;++ih){
    u32x4 zws[2];
    #pragma unroll
    for(int i=0;i<2;++i){const size_t grow=(size_t)(q0+wid*QBLK+(2*ih+i)*8+(lane>>3)); zws[i]=*(const u32x4*)(((bf16_t*)(P.ws + WS_PROJ))+grow*PITCH+(TYPE==0?C_AZ:C_BZ)+h*64+(lane&7)*8);}
    #pragma unroll
    for(int i2=0;i2<2;++i2){const int i=2*ih+i2; const int row=i*8+(lane>>3),ch=lane&7; const f32x4 v0=*(const f32x4*)(stgf+row*64+ch*8), v1=*(const f32x4*)(stgf+row*64+ch*8+4);
      const size_t grow=(size_t)(q0+wid*QBLK+row);
      const u32x4 zw=zws[i2];
      f32x4 a=v0,c=v1;
      if(TYPE==0){ float ss=(v0.x*v0.x+v0.y*v0.y)+(v0.z*v0.z+v0.w*v0.w)+(v1.x*v1.x+v1.y*v1.y)+(v1.z*v1.z+v1.w*v1.w);
        ss+=__shfl_xor(ss,1);ss+=__shfl_xor(ss,2);ss+=__shfl_xor(ss,4);
        const float rs=rsqrtf(ss*(1.f/64.f)+EPS)*post; a=a*rs*(*(const f32x4*)(sg+ch*8)); c=c*rs*(*(const f32x4*)(sg+ch*8+4)); }
      const u32x4 w={pk2(a.x*bflo(zw.x),a.y*bfhi(zw.x)),pk2(a.z*bflo(zw.y),a.w*bfhi(zw.y)),pk2(c.x*bflo(zw.z),c.y*bfhi(zw.z)),pk2(c.z*bflo(zw.w),c.w*bfhi(zw.w))};
      *(u32x4*)(((bf16_t*)(P.ws + WS_Y))+grow*DM+(TYPE==0?0:256)+h*64+ch*8)=w; } } }
  }
  #undef DMA_K
  #undef DMA_V
  #undef TROW
  #undef START
  #undef RESC
  #undef ROT
}
#undef SBAR
#undef WAIT_BAR
}
__device__ __forceinline__ bf16_t* of_row(const Params& P, int dir, int row) {
  const bool lat = row < NLAT; const int c = row - NLAT; const int x = lat ? (row >> 12) : (c >> 9), lr = lat ? (row & 4095) : 4096 + (c & 511);
  return ((bf16_t*)(P.ws + WS_XS)) + (size_t)x * (4096 * 1024) + ((size_t)dir * 4608 + lr) * 256;
}
namespace gla {
typedef short bf16x8 __attribute__((ext_vector_type(8)));
typedef float f32x16 __attribute__((ext_vector_type(16)));
__device__ __forceinline__ int crow(int r, int hi) { return (r & 3) + 8 * (r >> 2) + 4 * hi; }
constexpr int GRP_BYTES = 62464;
__device__ __forceinline__ size_t gblk(int chunk, int h, int dir) { return ((size_t)(chunk * 4 + h) * 2 + dir) * 2048; }
__device__ __forceinline__ int chunk_row0(int b, int cidx) { return cidx < 4 ? NLAT + b * CTXL + 64 * cidx : b * SEQ + 64 * (cidx - 4); }
__device__ __forceinline__ int p2_cidx(int dir, int step) { return dir == 0 ? step : (step < 4 ? 3 - step : 39 - step); }
struct P1In { float g[8]; u32x4 qw, kw, v0, v1; };
__device__ __forceinline__ P1In part1_load(const Params& P, int b, int h, int cidx) {
  const int tid = tid_now(), dir = tid >> 8, t4 = tid & 255; const int row0 = chunk_row0(b, cidx);
  P1In in; const int d = t4 & 31, seg = t4 >> 5;
#pragma unroll
  for (int e = 0; e < 8; ++e) { const int ip = 8 * seg + e; const int row = row0 + (dir ? 63 - ip : ip); in.g[e] = ((float*)(P.ws + WS_GATE))[gblk(row0 >> 6, h, dir) + (size_t)(row - row0) * 32 + d]; }
  const int prow = row0 + (dir ? 63 - (t4 >> 2) : (t4 >> 2));
  const bf16_t* pr_ = ((bf16_t*)(P.ws + WS_PROJ)) + (size_t)prow * NPROJ;
  in.qw = *(const u32x4*)(pr_ + C_DQ + h * 32 + 8 * (t4 & 3)); in.kw = *(const u32x4*)(pr_ + C_DK + h * 32 + 8 * (t4 & 3));
  in.v0 = *(const u32x4*)(pr_ + C_DV + h * 64 + 16 * (t4 & 3)); in.v1 = *(const u32x4*)(pr_ + C_DV + h * 64 + 16 * (t4 & 3) + 8);
  return in;
}
__device__ __forceinline__ void unit(const Params& P, int layer, int b, int h, unsigned char* lds) {
  const int tid = tid_now(), dir = tid >> 8, t4 = tid & 255, w4 = (tid >> 6) & 3, lane = tid & 63, r32 = lane & 31, hi = lane >> 5;
  unsigned char* base = lds + dir * GRP_BYTES;
  float* Gs = (float*)base;
  float* SEG = Gs + 64 * 33;
  float* GL = SEG + 256;
  bf16_t* QEs = (bf16_t*)(base + 9600);
  bf16_t* KDs = QEs + 64 * 40;
  bf16_t* KEt = KDs + 64 * 40;
  bf16_t* Vt = KEt + 32 * 72;
  bf16_t* As = Vt + 64 * 72;
  bf16_t* St = (bf16_t*)(base + 43008);
  bf16_t* Os = (bf16_t*)(base + 53248);
  f32x16 Sreg = {0.f, 0.f, 0.f, 0.f, 0.f, 0.f, 0.f, 0.f, 0.f, 0.f, 0.f, 0.f, 0.f, 0.f, 0.f, 0.f};
  __syncthreads();
#pragma unroll
  for (int i = 0; i < 5; ++i) ((unsigned*)St)[t4 + 256 * i] = 0u;
  P1In cur = part1_load(P, b, h, p2_cidx(dir, 0));
  for (int s = 0; s < 36; ++s) {
    const int cidx = p2_cidx(dir, s); const int row0 = chunk_row0(b, cidx);
    const P1In in = cur; cur = part1_load(P, b, h, p2_cidx(dir, s < 35 ? s + 1 : 35));
    const u32x4 qw = in.qw, kw = in.kw, v0 = in.v0, v1 = in.v1;
    __syncthreads();
    if (s > 0) { const int tok = t4 >> 2, sg = t4 & 3; const int rowp = chunk_row0(b, p2_cidx(dir, s - 1)) + tok;
      bf16_t* op = of_row(P, dir, rowp) + h * 64 + sg * 16;
      const u32x4 o0 = *(const u32x4*)(Os + tok * 72 + sg * 16), o1 = *(const u32x4*)(Os + tok * 72 + sg * 16 + 8); *(u32x4*)op = o0; *(u32x4*)(op + 8) = o1; }
    { const int d = t4 & 31, seg = t4 >> 5;
      float p[8]; float run = 0.f;
#pragma unroll
      for (int e = 0; e < 8; ++e) { run += in.g[e]; p[e] = run; }
      SEG[seg * 32 + d] = run;
      __syncthreads();
      float off = 0.f;
#pragma unroll
      for (int s2 = 0; s2 < 8; ++s2) { const float sv = SEG[s2 * 32 + d]; off += (s2 < seg) ? sv : 0.f; }
#pragma unroll
      for (int e = 0; e < 8; ++e) Gs[(8 * seg + e) * 33 + d] = p[e] + off;
      if (seg == 7) GL[d] = p[7] + off;
    }
    __syncthreads();
    { const int ip = t4 >> 2, o8 = t4 & 3;
      const float q[8] = {bflo(qw.x), bfhi(qw.x), bflo(qw.y), bfhi(qw.y), bflo(qw.z), bfhi(qw.z), bflo(qw.w), bfhi(qw.w)};
      const float k[8] = {bflo(kw.x), bfhi(kw.x), bflo(kw.y), bfhi(kw.y), bflo(kw.z), bfhi(kw.z), bflo(kw.w), bfhi(kw.w)};
      float qe[8], kd[8], ke[8];
#pragma unroll
      for (int e = 0; e < 8; ++e) { const float G = Gs[ip * 33 + 8 * o8 + e], gl = GL[8 * o8 + e]; qe[e] = q[e] * __expf(G); kd[e] = k[e] * __expf(-G); ke[e] = k[e] * __expf(gl - G); }
      *(u32x4*)(QEs + ip * 40 + 8 * o8) = (u32x4){pk2(qe[0], qe[1]), pk2(qe[2], qe[3]), pk2(qe[4], qe[5]), pk2(qe[6], qe[7])};
      *(u32x4*)(KDs + ip * 40 + 8 * o8) = (u32x4){pk2(kd[0], kd[1]), pk2(kd[2], kd[3]), pk2(kd[4], kd[5]), pk2(kd[6], kd[7])};
#pragma unroll
      for (int e = 0; e < 8; ++e) KEt[(8 * o8 + e) * 72 + ip] = (bf16_t)f2bf(ke[e]);
      const unsigned vw[8] = {v0.x, v0.y, v0.z, v0.w, v1.x, v1.y, v1.z, v1.w};
#pragma unroll
      for (int e = 0; e < 8; ++e) { Vt[(16 * o8 + 2 * e) * 72 + ip] = (bf16_t)(vw[e] & 0xffffu); Vt[(16 * o8 + 2 * e + 1) * 72 + ip] = (bf16_t)(vw[e] >> 16); }
    }
    __syncthreads();
    { const int it = w4 >> 1, jt = w4 & 1;
      f32x16 acc = {0.f, 0.f, 0.f, 0.f, 0.f, 0.f, 0.f, 0.f, 0.f, 0.f, 0.f, 0.f, 0.f, 0.f, 0.f, 0.f};
      if (!(it == 0 && jt == 1)) {
#pragma unroll
        for (int s2 = 0; s2 < 2; ++s2) { const bf16x8 a = *(const bf16x8*)(QEs + (32 * it + r32) * 40 + 16 * s2 + 8 * hi); const bf16x8 bb = *(const bf16x8*)(KDs + (32 * jt + r32) * 40 + 16 * s2 + 8 * hi);
          acc = __builtin_amdgcn_mfma_f32_32x32x16_bf16(a, bb, acc, 0, 0, 0); } }
#pragma unroll
      for (int r = 0; r < 16; ++r) { const int ip = 32 * it + crow(r, hi), jp = 32 * jt + r32; As[ip * 72 + jp] = (bf16_t)f2bf(jp <= ip ? acc[r] : 0.f); }
    }
    __syncthreads();
    { const int it = w4 >> 1, nt = w4 & 1;
      const bf16_t* Sc = St + (s & 1) * 2560; bf16_t* Sn = St + ((s + 1) & 1) * 2560;
      f32x16 acc = {0.f, 0.f, 0.f, 0.f, 0.f, 0.f, 0.f, 0.f, 0.f, 0.f, 0.f, 0.f, 0.f, 0.f, 0.f, 0.f};
#pragma unroll
      for (int s2 = 0; s2 < 4; ++s2) { const bf16x8 a = *(const bf16x8*)(As + (32 * it + r32) * 72 + 16 * s2 + 8 * hi); const bf16x8 bb = *(const bf16x8*)(Vt + (32 * nt + r32) * 72 + 16 * s2 + 8 * hi);
        acc = __builtin_amdgcn_mfma_f32_32x32x16_bf16(a, bb, acc, 0, 0, 0); }
#pragma unroll
      for (int s2 = 0; s2 < 2; ++s2) { const bf16x8 a = *(const bf16x8*)(QEs + (32 * it + r32) * 40 + 16 * s2 + 8 * hi); const bf16x8 bb = *(const bf16x8*)(Sc + (32 * nt + r32) * 40 + 16 * s2 + 8 * hi);
        acc = __builtin_amdgcn_mfma_f32_32x32x16_bf16(a, bb, acc, 0, 0, 0); }
#pragma unroll
      for (int r = 0; r < 16; ++r) { const int ip = 32 * it + crow(r, hi); Os[(dir ? 63 - ip : ip) * 72 + 32 * nt + r32] = (bf16_t)f2bf(acc[r]); }
      if (w4 < 2) {
        f32x16 au = {0.f, 0.f, 0.f, 0.f, 0.f, 0.f, 0.f, 0.f, 0.f, 0.f, 0.f, 0.f, 0.f, 0.f, 0.f, 0.f};
#pragma unroll
        for (int s2 = 0; s2 < 4; ++s2) { const bf16x8 a = *(const bf16x8*)(KEt + r32 * 72 + 16 * s2 + 8 * hi); const bf16x8 bb = *(const bf16x8*)(Vt + (32 * w4 + r32) * 72 + 16 * s2 + 8 * hi);
          au = __builtin_amdgcn_mfma_f32_32x32x16_bf16(a, bb, au, 0, 0, 0); }
#pragma unroll
        for (int r = 0; r < 16; ++r) Sreg[r] = __expf(GL[crow(r, hi)]) * Sreg[r] + au[r];
#pragma unroll
        for (int q = 0; q < 4; ++q) *(u32x2*)(Sn + (32 * w4 + r32) * 40 + 8 * q + 4 * hi) = (u32x2){pk2(Sreg[4 * q], Sreg[4 * q + 1]), pk2(Sreg[4 * q + 2], Sreg[4 * q + 3])};
      }
    }
  }
  __syncthreads();
  { const int tok = t4 >> 2, sg = t4 & 3; const int rowp = chunk_row0(b, p2_cidx(dir, 35)) + tok;
    bf16_t* op = of_row(P, dir, rowp) + h * 64 + sg * 16;
    const u32x4 o0 = *(const u32x4*)(Os + tok * 72 + sg * 16), o1 = *(const u32x4*)(Os + tok * 72 + sg * 16 + 8); *(u32x4*)op = o0; *(u32x4*)(op + 8) = o1; }
  asm volatile("s_waitcnt vmcnt(0)" ::: "memory");
  __syncthreads();
  { const int wave = tid >> 6; const bool last = layer == DEPTH - 1;
    const int v4 = (lane & 15) * 4; const f32x4 g4 = *(const f32x4*)(PVEC(P) + PV_GLAG + layer * 64 + v4);
    for (int grp = 0; grp < 8; ++grp) {
      u32x2 a[9], bq[9], zw[9];
#pragma unroll
      for (int k = 0; k < 9; ++k) { const int itx = wave + 8 * (9 * grp + k); const int r = itx * 4 + (lane >> 4), cidx = r >> 6, ri = r & 63; const size_t row = (size_t)chunk_row0(b, cidx) + ri;
        a[k] = *(const u32x2*)(of_row(P, 0, (int)row) + h * 64 + v4); bq[k] = *(const u32x2*)(of_row(P, 1, (int)row) + h * 64 + v4);
        zw[k] = *(const u32x2*)(((bf16_t*)(P.ws + WS_PROJ)) + row * NPROJ + C_DZ + h * 64 + v4); }
#pragma unroll
      for (int k = 0; k < 9; ++k) { const int itx = wave + 8 * (9 * grp + k); const int r = itx * 4 + (lane >> 4), cidx = r >> 6, ri = r & 63; const size_t row = (size_t)chunk_row0(b, cidx) + ri;
        const f32x4 o = {bflo(a[k].x) + bflo(bq[k].x), bfhi(a[k].x) + bfhi(bq[k].x), bflo(a[k].y) + bflo(bq[k].y), bfhi(a[k].y) + bfhi(bq[k].y)};
        float ss = (o.x * o.x + o.y * o.y) + (o.z * o.z + o.w * o.w);
        ss += __shfl_xor(ss, 1); ss += __shfl_xor(ss, 2); ss += __shfl_xor(ss, 4); ss += __shfl_xor(ss, 8);
        const float rs = rsqrtf(ss * (1.f / 64.f) + EPS);
        if (!(last && cidx < 4)) *(u32x2*)(((bf16_t*)(P.ws + WS_Y)) + row * DM + 768 + h * 64 + v4) = (u32x2){pk2(o.x * rs * g4.x * bflo(zw[k].x), o.y * rs * g4.y * bfhi(zw[k].x)), pk2(o.z * rs * g4.z * bflo(zw[k].y), o.w * rs * g4.w * bfhi(zw[k].y))}; }
    }
  }
  __syncthreads();
}
}
struct SguIn { u32x4 w[8]; };
__device__ __forceinline__ SguIn sgu_load(const Params& P, int ch) {
  const int tid = tid_now(); const int pos = tid >> 2, q4 = tid & 3; const bf16_t* src = ((bf16_t*)(P.ws + WS_PROJ)) + (size_t)(ch * 128 + pos) * NPROJ + C_CV + q4 * 64;
  SguIn in;
#pragma unroll
  for (int c = 0; c < 8; ++c) in.w[c] = *(const u32x4*)(src + 8 * c);
  return in;
}
__device__ __forceinline__ void sgu_unit(const Params& P, int layer, int ch, const SguIn& sin, unsigned char* lds) {
  typedef short bf16x8 __attribute__((ext_vector_type(8)));
  typedef float f32x16 __attribute__((ext_vector_type(16)));
  bf16_t* vnT = (bf16_t*)lds;
  const int tid = tid_now(), wave = tid >> 6, lane = tid & 63, r32 = lane & 31, hi = lane >> 5; const int row0 = ch * 128;
  const int g = wave >> 1, ct = wave & 1;
  bf16_t* Ub = (bf16_t*)(lds + 69632 + wave * 5120); bf16_t* Zb = Ub + 1280;
  float* sgb = (float*)(lds + 110592);
  float* lgs = (float*)(lds + 112640);
  const bf16_t* W = (const bf16_t*)(P.ws + WS_SGW) + (size_t)(layer * 4 + g) * 128 * 128;
  const int cb = g * 64 + 32 * ct, lrow = lane >> 1, lhalf = lane & 1;
  const bf16_t* pj = ((bf16_t*)(P.ws + WS_PROJ)) + (size_t)(row0 + lrow) * NPROJ + cb + lhalf * 16;
  bf16_t* yo = ((bf16_t*)(P.ws + WS_Y)) + (size_t)(row0 + lrow) * DM + 512 + cb + lhalf * 16;
  const float sv = PVEC(P)[PV_SGB + layer * 512 + tid], lv = tid < 256 ? PVEC(P)[PV_LNG + layer * 256 + tid] : PVEC(P)[PV_LNB + layer * 256 + tid - 256];
  bf16x8 wA[8], wB[8]; u32x4 uz[4][4];
#define SGU_LOAD(w_, it_) do { _Pragma("unroll") for (int s = 0; s < 8; ++s) w_[s] = *(const bf16x8*)(W + (size_t)(32 * (it_) + r32) * 128 + 16 * s + 8 * hi); } while (0)
#define SGU_PUT(it_) do { *(u32x4*)(Ub + lrow * 40 + lhalf * 16) = uz[it_][0]; *(u32x4*)(Ub + lrow * 40 + lhalf * 16 + 8) = uz[it_][1]; *(u32x4*)(Zb + lrow * 40 + lhalf * 16) = uz[it_][2]; *(u32x4*)(Zb + lrow * 40 + lhalf * 16 + 8) = uz[it_][3]; } while (0)
#define SGU_TILE(w_, it_) do { f32x16 acc = {0.f, 0.f, 0.f, 0.f, 0.f, 0.f, 0.f, 0.f, 0.f, 0.f, 0.f, 0.f, 0.f, 0.f, 0.f, 0.f}; \
      _Pragma("unroll") for (int s = 0; s < 8; ++s) acc = __builtin_amdgcn_mfma_f32_32x32x16_bf16(w_[s], bfr[s], acc, 0, 0, 0); \
      float ov[16]; \
      _Pragma("unroll") for (int r = 0; r < 16; ++r) { const int il = (r & 3) + 8 * (r >> 2) + 4 * hi; ov[r] = bf2f(Ub[il * 40 + r32]) * (acc[r] + sgb[g * 128 + 32 * (it_) + il]) * bf2f(Zb[il * 40 + r32]); } \
      _Pragma("unroll") for (int r = 0; r < 16; ++r) { const int il = (r & 3) + 8 * (r >> 2) + 4 * hi; Ub[il * 40 + r32] = (bf16_t)f2bf(ov[r]); } \
      const u32x4 o0 = *(const u32x4*)(Ub + lrow * 40 + lhalf * 16), o1 = *(const u32x4*)(Ub + lrow * 40 + lhalf * 16 + 8); \
      bf16_t* y_ = yo + (size_t)(32 * (it_)) * DM; *(u32x4*)y_ = o0; *(u32x4*)(y_ + 8) = o1; } while (0)
  SGU_LOAD(wA, 0);
#pragma unroll
  for (int it = 0; it < 4; ++it) { const bf16_t* p_ = pj + (size_t)(32 * it) * NPROJ; uz[it][0] = *(const u32x4*)(p_ + C_CU); uz[it][1] = *(const u32x4*)(p_ + C_CU + 8); uz[it][2] = *(const u32x4*)(p_ + C_CZ); uz[it][3] = *(const u32x4*)(p_ + C_CZ + 8); }
  sgb[tid] = sv; lgs[tid] = lv;
  __syncthreads();
  { const int pos = tid >> 2, q4 = tid & 3;
    float x[64];
#pragma unroll
    for (int c = 0; c < 8; ++c) { const u32x4 w = sin.w[c]; x[8 * c] = bflo(w.x); x[8 * c + 1] = bfhi(w.x); x[8 * c + 2] = bflo(w.y); x[8 * c + 3] = bfhi(w.y); x[8 * c + 4] = bflo(w.z); x[8 * c + 5] = bfhi(w.z); x[8 * c + 6] = bflo(w.w); x[8 * c + 7] = bfhi(w.w); }
    float s = 0.f;
#pragma unroll
    for (int c = 0; c < 64; ++c) s += x[c];
    s += __shfl_xor(s, 1); s += __shfl_xor(s, 2);
    const float mu = s * (1.f / 256.f); float s2 = 0.f;
#pragma unroll
    for (int c = 0; c < 64; ++c) { const float d = x[c] - mu; s2 += d * d; }
    s2 += __shfl_xor(s2, 1); s2 += __shfl_xor(s2, 2);
    const float rstd = rsqrtf(s2 * (1.f / 256.f) + EPS);
    const float* lg = lgs + q4 * 64; const float* lb = lgs + 256 + q4 * 64;
#pragma unroll
    for (int c = 0; c < 64; ++c) vnT[(q4 * 64 + c) * 136 + pos] = (bf16_t)f2bf((x[c] - mu) * rstd * lg[c] + lb[c]); }
  __syncthreads();
  { bf16x8 bfr[8];
#pragma unroll
    for (int s = 0; s < 8; ++s) bfr[s] = *(const bf16x8*)(vnT + (g * 64 + 32 * ct + r32) * 136 + 16 * s + 8 * hi);
    SGU_PUT(0);
    SGU_LOAD(wB, 1); SGU_TILE(wA, 0); SGU_PUT(1);
    SGU_LOAD(wA, 2); SGU_TILE(wB, 1); SGU_PUT(2);
    SGU_LOAD(wB, 3); SGU_TILE(wA, 2); SGU_PUT(3);
    SGU_TILE(wB, 3);
#undef SGU_LOAD
#undef SGU_PUT
#undef SGU_TILE
  }
  __syncthreads();
}
constexpr int XQ_A0 = 0, XQ_B0 = 64, XQ_S0 = 128, XQ_CA0 = 164, XQ_CB0 = 172, XQ_N = 180;
__device__ __forceinline__ int xq_pull(unsigned* ctr, int x0, int& lst) {
  if (gridDim.x == 256 && lst > 0) lst = 8;
  while (lst < 8) { const int x = (x0 + lst) & 7; const unsigned u = atomicAdd(ctr + x * 64, 1u); if (u < (unsigned)XQ_N) return x * 256 + (int)u; lst = gridDim.x == 256 ? 8 : lst + 1; }
  return -1;
}
__device__ __forceinline__ int xq_attn(int code, bool last) {
  if (code < 0) return -1;
  const int x = code >> 8, u = code & 255; int g, t;
  if (u < XQ_B0) { g = 8 * x + ((u - XQ_A0) >> 3); t = 0; }
  else if (u < XQ_S0) { g = 8 * x + ((u - XQ_B0) >> 3); t = 1; }
  else if (u < XQ_CA0 || last) return -1;
  else if (u < XQ_CB0) { g = 8 * x + (u - XQ_CA0); t = 0; }
  else { g = 8 * x + (u - XQ_CB0); t = 1; }
  return (t << 12) | ((g >> 2) << 4) | (g & 3);
}
__device__ __forceinline__ void mix_phase(const Params& P, int layer, unsigned char* lds, unsigned* ctr) {
  volatile __attribute__((address_space(3))) int* shu = (volatile __attribute__((address_space(3))) int*)((__attribute__((address_space(3))) unsigned char*)lds + LDS_BYTES - 64);
  const bool last = layer == DEPTH - 1;
  for (int g = (int)blockIdx.x; g < 64; g += (int)gridDim.x) gla::unit(P, layer, 2 * (g & 7) + (g >> 5), (g >> 3) & 3, lds);
  __syncthreads();
  if (tid_now() == 0) { int lst = 0; const int x0 = (int)(blockIdx.x & 7); shu[0] = xq_pull(ctr, x0, lst); shu[1] = xq_pull(ctr, x0, lst); shu[2] = lst; shu[3] = 0; }
  __syncthreads();
  for (;;) {
    const int c0 = __builtin_amdgcn_readfirstlane(shu[0]);
    if (c0 < 0) break;
    unsigned pend = 0u;
    if (tid_now() == 0) { const int lst = shu[2]; if (lst < 8) pend = atomicAdd(ctr + (((int)(blockIdx.x & 7) + lst) & 7) * 64, 1u); }
    { const int x = c0 >> 8, u = c0 & 255; const int an = xq_attn(c0, last), nx = xq_attn(__builtin_amdgcn_readfirstlane(shu[1]), last); const bool pre = __builtin_amdgcn_readfirstlane(shu[3]) != 0;
      __syncthreads();
      if (tid_now() == 0) shu[3] = (an >= 0 && nx >= 0) ? 1 : 0;
      if (an >= 0) { const int b = (an >> 4) & 15, h = an & 3;
        if (u < XQ_S0) { const int qb = (u - XQ_A0) & 7; if ((an >> 12) == 0) att::attn_unit<0, 8>(P, layer, b, h, qb, (char*)lds, pre, nx); else att::attn_unit<1, 8>(P, layer, b, h, qb, (char*)lds, pre, nx); }
        else { if ((an >> 12) == 0) att::attn_unit<0, 8>(P, layer, b, h, 8, (char*)lds, pre, nx); else att::attn_unit<1, 8>(P, layer, b, h, 8, (char*)lds, pre, nx); } }
      else if (u >= XQ_S0 && u < XQ_CA0) { const int k = u - XQ_S0; const int ch = k < 32 ? 32 * x + k : 256 + 4 * x + (k - 32);
        if (!(last && k >= 32)) { const SguIn si = sgu_load(P, ch); sgu_unit(P, layer, ch, si, lds); } } }
    __syncthreads();
    if (tid_now() == 0) { int lst = shu[2]; const int x0 = (int)(blockIdx.x & 7); int c2 = -1;
      if (lst < 8) { if (pend < (unsigned)XQ_N) c2 = ((x0 + lst) & 7) * 256 + (int)pend; else { ++lst; c2 = xq_pull(ctr, x0, lst); } }
      shu[0] = shu[1]; shu[1] = c2; shu[2] = lst; }
    __syncthreads();
  }
}

#define LAS __attribute__((address_space(3)))
#define XB_TMO      128
#define XB_XCNT(j)  (256  + 64 * (j))
#define XB_XSUB(j)  (1280 + 64 * (j))
#define XB_XGEN(j)  (2304 + 64 * (j))
#define XB_TOP      3328
#define XB_TOPGEN   3392
#define XCD_BAR_WORDS 3456
#define XB_SPIN_CAP (1u << 18)

__device__ __forceinline__ unsigned xb_ld(unsigned* p)              { return __hip_atomic_load(p, __ATOMIC_RELAXED, __HIP_MEMORY_SCOPE_AGENT); }
__device__ __forceinline__ unsigned xb_add(unsigned* p, unsigned v) { return __hip_atomic_fetch_add(p, v, __ATOMIC_RELAXED, __HIP_MEMORY_SCOPE_AGENT); }
__device__ __forceinline__ unsigned xb_xcc_id() { return (unsigned)__builtin_amdgcn_s_getreg((3 << 11) | 20) & 0xFu; }
#define XB_SPIN(cond, bar) do { unsigned _sp = 0; while (cond) { __builtin_amdgcn_s_sleep(1); \
    if ((++_sp & 255u) == 0u) { if (xb_ld(&(bar)[XB_TMO])) break; if (_sp > XB_SPIN_CAP) { atomicAdd(&(bar)[XB_TMO], 1u); break; } } } } while (0)

struct XcdBarrier {
    unsigned* bar; unsigned x;
    volatile LAS unsigned* st;
};

__device__ __forceinline__ XcdBarrier xcd_barrier_post(unsigned* bar, volatile LAS unsigned* st) {
    XcdBarrier b; b.bar = bar; b.x = xb_xcc_id(); b.st = st;
    if (threadIdx.x == 0) (void)xb_add(&bar[XB_XCNT(b.x)], 1u);
    return b;
}
__device__ __forceinline__ void xcd_barrier_complete(unsigned* bar, unsigned x, unsigned& nloc, unsigned& nx) {
    const unsigned G = gridDim.x * gridDim.y * gridDim.z;
    unsigned sum, cnt, mine, sp = 0u;
    for (;;) {
        sum = 0u; cnt = 0u; mine = 0u;
#pragma unroll
        for (unsigned j = 0; j < 16; ++j) { const unsigned c = xb_ld(&bar[XB_XCNT(j)]); sum += c; cnt += (c > 0u) ? 1u : 0u; mine = (j == x) ? c : mine; }
        if (sum == G) break;
        __builtin_amdgcn_s_sleep(1);
        if ((++sp & 255u) == 0u) { if (xb_ld(&bar[XB_TMO])) break; if (sp > XB_SPIN_CAP) { atomicAdd(&bar[XB_TMO], 1u); break; } }
    }
    nloc = mine > 0u ? mine : 1u; nx = cnt > 0u ? cnt : 1u;
}

__device__ __forceinline__ void xcd_barrier(const XcdBarrier& b) {
    asm volatile("s_waitcnt vmcnt(0)" ::: "memory");
    __syncthreads();
    if (threadIdx.x == 0) {
        unsigned* bar = b.bar;
        __builtin_amdgcn_s_waitcnt(0);
        unsigned nloc = b.st[0], nx = b.st[1];
        if (nloc == 0u) { xcd_barrier_complete(bar, b.x, nloc, nx); b.st[0] = nloc; b.st[1] = nx; }
        const unsigned old = xb_add(&bar[XB_XSUB(b.x)], 1u);
        const unsigned gen = old / nloc;
        if (old + 1u == (gen + 1u) * nloc) {
            __builtin_amdgcn_fence(__ATOMIC_RELEASE, "agent");
            asm volatile("s_waitcnt vmcnt(0)" ::: "memory");
            const unsigned og = xb_add(&bar[XB_TOP], 1u);
            const unsigned tg = og / nx;
            if (og + 1u == (tg + 1u) * nx) xb_add(&bar[XB_TOPGEN], 1u);
            else XB_SPIN(xb_ld(&bar[XB_TOPGEN]) == tg, bar);
            __builtin_amdgcn_fence(__ATOMIC_ACQUIRE, "agent");
            xb_add(&bar[XB_XGEN(b.x)], 1u);
            asm volatile("s_waitcnt vmcnt(0)" ::: "memory");
        } else {
            XB_SPIN(xb_ld(&bar[XB_XGEN(b.x)]) == gen, bar);
            __builtin_amdgcn_fence(__ATOMIC_ACQUIRE, "agent");
            asm volatile("s_waitcnt vmcnt(0)" ::: "memory");
        }
    }
    __syncthreads();
}

__device__ __forceinline__ unsigned l2_add(unsigned* p, unsigned v) { unsigned r; asm volatile("global_atomic_add %0, %1, %2, off sc0\n\ts_waitcnt vmcnt(0)" : "=&v"(r) : "v"(p), "v"(v) : "memory"); return r; }
__device__ __forceinline__ void xgroup_barrier(unsigned* cnt, bool local) {
  asm volatile("s_waitcnt vmcnt(0)" ::: "memory");
  __syncthreads();
  if (threadIdx.x == 0) {
    unsigned sp = 0u;
    if (local) {
      const unsigned old = l2_add(cnt, 1u); const unsigned tgt = (old / 32u + 1u) * 32u;
      while (l2_add(cnt, 0u) < tgt) { __builtin_amdgcn_s_sleep(1); if (++sp > (1u << 20)) break; }
    } else {
      __builtin_amdgcn_fence(__ATOMIC_RELEASE, "agent");
      asm volatile("s_waitcnt vmcnt(0)" ::: "memory");
      const unsigned old = __hip_atomic_fetch_add(cnt, 1u, __ATOMIC_RELAXED, __HIP_MEMORY_SCOPE_AGENT); const unsigned tgt = (old / 32u + 1u) * 32u;
      while (__hip_atomic_load(cnt, __ATOMIC_RELAXED, __HIP_MEMORY_SCOPE_AGENT) < tgt) { __builtin_amdgcn_s_sleep(1); if (++sp > (1u << 22)) break; }
    }
    __builtin_amdgcn_fence(__ATOMIC_ACQUIRE, "agent");
    asm volatile("s_waitcnt vmcnt(0)" ::: "memory");
  }
  __syncthreads();
}
__global__ void __launch_bounds__(NTHREADS, 2) mega(Params P) {
  extern __shared__ __attribute__((aligned(16))) unsigned char lds[];
  cg::grid_group grid = cg::this_grid();
  float* ldsf = (float*)lds;
  volatile LAS unsigned* xst = (volatile LAS unsigned*)((LAS unsigned char*)lds + LDS_BYTES - 32);
  if (threadIdx.x < 2) xst[threadIdx.x] = 0u;
  __syncthreads();
  (void)xcd_barrier_post(((unsigned*)(P.ws + WS_CTL)) + 4096, xst);
  if (threadIdx.x == 0) __hip_atomic_store(((unsigned*)(P.ws + WS_CTL)) + 65536 + blockIdx.x, xb_xcc_id() + 1u, __ATOMIC_RELAXED, __HIP_MEMORY_SCOPE_AGENT);
#define GSYNC() do { XcdBarrier xb_; xb_.bar = ((unsigned*)(P.ws + WS_CTL)) + 4096; xb_.x = xb_xcc_id(); xb_.st = (volatile LAS unsigned*)((LAS unsigned char*)lds + LDS_BYTES - 32); xcd_barrier(xb_); } while (0)
  p0_mod(P, ldsf); p0_tables(P); p0_fold(P); p0_weights<0>(P, ldsf, 0, 1, 0);
  if (P.ws == nullptr) grid.sync();
  GSYNC();
  p0_weights<1>(P, ldsf, 0, 1, 0); __syncthreads(); p0_bias(P, ldsf, 0, DEPTH, 0); p0_xs(P);
  GSYNC();
  if (threadIdx.x == 0) { unsigned same = gridDim.x == 256 ? 1u : 0u; const unsigned mine = xb_xcc_id() + 1u;
    if (same) for (int j = 0; j < 32; ++j) same &= (__hip_atomic_load(((unsigned*)(P.ws + WS_CTL)) + 65536 + j * 8 + (blockIdx.x & 7), __ATOMIC_RELAXED, __HIP_MEMORY_SCOPE_AGENT) == mine) ? 1u : 0u;
    xst[2] = same; }
  __syncthreads();
#define XSYNC() do { if (gridDim.x == 256) xgroup_barrier(((unsigned*)(P.ws + WS_CTL)) + 8192 + 64 * (blockIdx.x & 7), ((volatile LAS unsigned*)((LAS unsigned char*)lds + LDS_BYTES - 32))[2] != 0u); else GSYNC(); } while (0)
  for (int i = tid_now(); i < 3080; i += NTHREADS) ((float*)(lds + LDS_TAB))[i] = ((float*)(P.ws + WS_TAB))[i];
  Params Pl = P;
#define OPQ() do { __attribute__((address_space(1))) unsigned char* g_ = (__attribute__((address_space(1))) unsigned char*)Pl.ws; asm volatile("" : "+s"(g_)); Pl.ws = (unsigned char*)g_; } while (0)
  for (int layer = 0; layer < DEPTH; ++layer) {
    OPQ();
    { EpiIn E{Pl, layer, (const float*)(lds + LDS_RSTD), (const float*)(lds + LDS_TAB), (const float*)(lds + LDS_BIASU), (const float*)(lds + LDS_QKN)}; pg8::Gemm g{((bf16_t*)(Pl.ws + WS_XS)), ((bf16_t*)(Pl.ws + WS_WTIN)) + (size_t)layer * NPROJ * DM, MROWS, NPROJ, DM}; pg8::XcdOrder S; int bid_ = (int)blockIdx.x; asm volatile("" : "+s"(bid_)); if (gridDim.x == 256) S.init(18, NPROJ / 256, 32, bid_ >> 3, 16 * (bid_ & 7), 128 + 2 * (bid_ & 7), 16); else S.init(MROWS / 256, NPROJ / 256, (int)gridDim.x, bid_, 0, 128, 128);
      { const int t_ = tid_now(); pg8::Unit u_;
#pragma unroll
        for (int ui = 0; ui < 8; ++ui) if (S.next(ui, u_)) { const int r_ = t_ & 255, hf = t_ >> 8; const float* sp = ((float*)(Pl.ws + WS_SSP)) + (size_t)(8 * hf) * MROWS + u_.pm * 256 + r_;
          float s_ = 0.f;
#pragma unroll
          for (int j = 0; j < 8; ++j) s_ += sp[(size_t)j * MROWS];
          ((float*)lds)[(ui * 2 + hf) * 256 + r_] = s_;
          if (t_ < 256) ((float*)(lds + LDS_BIASU))[ui * 256 + t_] = ((float*)(Pl.ws + WS_BIAS))[(size_t)(layer * 17 + (u_.pm < 128 ? (u_.pm >> 3) : 16)) * NPROJ + u_.pn * 256 + t_]; }
        __syncthreads();
#pragma unroll
        for (int ui = 0; ui < 8; ++ui) if (S.next(ui, u_) && t_ < 256) ((float*)(lds + LDS_RSTD))[ui * 256 + t_] = rsqrtf((((float*)lds)[(ui * 2) * 256 + t_] + ((float*)lds)[(ui * 2 + 1) * 256 + t_]) * (1.f / DM) + EPS);
        if (t_ >= 256 && t_ < 384) ((float*)(lds + LDS_QKN))[t_ - 256] = PVEC(Pl)[(t_ < 320 ? PV_QN : PV_KN) + layer * 64 + (t_ & 63)];
        __syncthreads(); }
      pg8::gemm_phase<EpiIn, pg8::XcdOrder, true, true>((PG8_LAS unsigned char*)lds, g, S, E);
    }
    XSYNC(); OPQ();
    mix_phase(Pl, layer, lds, ((unsigned*)(Pl.ws + WS_CTL)) + 512 * layer);
    XSYNC(); OPQ();
    { const int Mo = layer == DEPTH - 1 ? NLAT : MROWS; pg8::Gemm g{((bf16_t*)(Pl.ws + WS_Y)), ((bf16_t*)(Pl.ws + WS_WTOUT)) + (size_t)layer * DM * DM, Mo, DM, DM}; pg8::XcdOrder S; int bid_ = (int)blockIdx.x; asm volatile("" : "+s"(bid_)); if (gridDim.x == 256) S.init(Mo / 256 / 8, DM / 256, 32, bid_ >> 3, 16 * (bid_ & 7), 128 + 2 * (bid_ & 7), 16); else S.init(Mo / 256, DM / 256, (int)gridDim.x, bid_, 0, 128, 128);
      if (layer == 0) { EpiOut<true, false> E{Pl, layer}; pg8::gemm_phase<EpiOut<true, false>, pg8::XcdOrder, true, true>((PG8_LAS unsigned char*)lds, g, S, E); }
      else if (layer < DEPTH - 1) { EpiOut<false, false> E{Pl, layer}; pg8::gemm_phase<EpiOut<false, false>, pg8::XcdOrder, true, true>((PG8_LAS unsigned char*)lds, g, S, E); }
      else { EpiOut<false, true> E{Pl, layer}; pg8::gemm_phase<EpiOut<false, true>, pg8::XcdOrder, true, true>((PG8_LAS unsigned char*)lds, g, S, E); }
      if (layer < DEPTH - 1) { const int b0 = gridDim.x == 256 ? 64 : 0; __syncthreads(); p0_weights<2>(Pl, (float*)lds, layer + 1, layer + 2, b0);
        if (gridDim.x == 256 && (int)blockIdx.x >= b0) { asm volatile("s_waitcnt vmcnt(0)" ::: "memory"); __syncthreads();
          if (threadIdx.x == 0) { __builtin_amdgcn_fence(__ATOMIC_RELEASE, "agent"); asm volatile("s_waitcnt vmcnt(0)" ::: "memory"); (void)xb_add(((unsigned*)(Pl.ws + WS_CTL)) + 12288 + 64 * (layer + 1), 1u); } } } }
    if (layer < DEPTH - 1) XSYNC(); else GSYNC();
    OPQ();
    if (gridDim.x == 256 && layer < DEPTH - 1) {
      if (threadIdx.x == 0) { unsigned sp = 0u; while (xb_ld(((unsigned*)(Pl.ws + WS_CTL)) + 12288 + 64 * (layer + 1)) < 192u) { __builtin_amdgcn_s_sleep(1); if (++sp > (1u << 22)) break; }
        __builtin_amdgcn_fence(__ATOMIC_ACQUIRE, "agent"); asm volatile("s_waitcnt vmcnt(0)" ::: "memory"); }
      __syncthreads(); }
  }
  final_norm(P);
}

extern "C" void kernel_launch(void* const* d_in, const int* in_sizes, int n_in, void* d_out, int out_size, void* d_ws, size_t ws_size, hipStream_t stream) {
  static int grid_blocks = 0;
  if (!grid_blocks) {
    int dev = 0, cus = 0, per_cu = 0;
    (void)hipGetDevice(&dev);
    (void)hipDeviceGetAttribute(&cus, hipDeviceAttributeMultiprocessorCount, dev);
    (void)hipFuncSetAttribute((const void*)mega, hipFuncAttributeMaxDynamicSharedMemorySize, LDS_BYTES);
    (void)hipOccupancyMaxActiveBlocksPerMultiprocessor(&per_cu, (const void*)mega, NTHREADS, LDS_BYTES);
    if (per_cu < 1) per_cu = 1;
    grid_blocks = cus * per_cu;
    if (ws_size < WS_END || n_in != 26) { fprintf(stderr, "kernel_launch: bad ws_size %zu / n_in %d\n", ws_size, n_in); grid_blocks = -1; }
  }
  if (grid_blocks < 0) return;
  (void)hipMemsetAsync((char*)d_ws + WS_CTL, 0, 1 * MiB, stream);
  Params p{};
  const float** pin = (const float**)&p;
  for (int i = 0; i < 26; ++i) pin[i] = (const float*)d_in[i];
  unsigned char* ws = (unsigned char*)d_ws;
  p.out = (float*)d_out;
  p.ws = ws;
  void* args[] = {&p};
  hipError_t e = hipLaunchCooperativeKernel((void*)mega, dim3(grid_blocks), dim3(NTHREADS), args, LDS_BYTES, stream);
  if (e != hipSuccess) fprintf(stderr, "cooperative launch failed: %s (grid %d)\n", hipGetErrorString(e), grid_blocks);
}
```

```cpp
#include <hip/hip_runtime.h>
#include <hip/hip_cooperative_groups.h>
#include <cstdio>
#include <cstdint>
namespace cg = cooperative_groups;

typedef unsigned short bf16_t;
typedef float f32x4 __attribute__((ext_vector_type(4)));
typedef unsigned u32x4 __attribute__((ext_vector_type(4)));
typedef unsigned u32x2 __attribute__((ext_vector_type(2)));

constexpr int NTHREADS = 512;
constexpr int LDS_BYTES = 163840;
constexpr int LDS_RSTD = 131072, LDS_TAB = 139264, LDS_BIASU = 151584, LDS_QKN = 159776;
constexpr int DM = 1024, SEQ = 2048, NB = 16, CTXL = 256, DEPTH = 4;
constexpr int NLAT = NB * SEQ, NCTX = NB * CTXL, MROWS = NLAT + NCTX;
constexpr int PINW = 3360, NPROJ = 3584;
constexpr float EPS = 1e-6f;
constexpr float LOG2E = 1.4426950408889634f;
constexpr int C_AQ = 0, C_AK = 256, C_AV = 512, C_AZ = 768, C_BQ = 1024, C_BK = 1280, C_BV = 1408, C_BZ = 1536,
              C_CU = 1792, C_CV = 2048, C_CZ = 2304, C_DQ = 2560, C_DK = 2688, C_DV = 2816, C_DZ = 3072;
constexpr size_t MiB = 1u << 20;
constexpr size_t WS_CTL = 0, WS_MOD = 1 * MiB, WS_BIAS = 2 * MiB, WS_TAB = 3 * MiB, WS_SSP = 4 * MiB, WS_WTIN = 8 * MiB, WS_WTOUT = 36 * MiB,
                 WS_XC = 44 * MiB, WS_XS = 64 * MiB, WS_Y = 136 * MiB, WS_PROJ = 208 * MiB, WS_GATE = 460 * MiB, WS_WG = 496 * MiB, WS_DVEC = 500 * MiB, WS_END = 502 * MiB;

struct Params {
  const float *x, *c, *ctx, *c_ctx, *ada_w, *ada_b, *norm_g, *w_in, *lq1, *lk1, *lq2, *lk2, *subln_g, *qn_g, *kn_g,
      *ln_g, *ln_b, *sg_w, *sg_b, *w2_f, *b_f, *w2_b, *b_b, *gla_g, *w_out, *final_g;
  float* out;
  unsigned char* ws;
};
constexpr int T_COSA = 0, T_SINA = 512, T_COSB = 1024, T_SINB = 2048, T_LAM = 3072, T_LAMI = 3076;
constexpr size_t WS_PV = WS_TAB + 16384, WS_SGW = WS_TAB + 65536;
constexpr int PV_SUBLN = 0, PV_QN = 256, PV_KN = 512, PV_GLAG = 768, PV_LNG = 1024, PV_LNB = 2048, PV_SGB = 3072, PV_NORMG = 5120, PV_TOTAL = 9216;
#define PVEC(P) ((const float*)((P).ws + WS_PV))

__device__ __forceinline__ unsigned f2bf(float f) { unsigned u = __builtin_bit_cast(unsigned, f); return (u + 0x7fffu + ((u >> 16) & 1u)) >> 16; }
typedef float f32x2_c __attribute__((ext_vector_type(2))); typedef __bf16 bf16x2_c __attribute__((ext_vector_type(2)));
__device__ __forceinline__ unsigned pk2(float lo, float hi) { const f32x2_c v = {lo, hi}; return __builtin_bit_cast(unsigned, __builtin_convertvector(v, bf16x2_c)); }
__device__ __forceinline__ float bflo(unsigned w) { return __builtin_bit_cast(float, w << 16); }
__device__ __forceinline__ float bfhi(unsigned w) { return __builtin_bit_cast(float, w & 0xffff0000u); }
__device__ __forceinline__ float bf2f(bf16_t h) { return __builtin_bit_cast(float, (unsigned)h << 16); }
__device__ __forceinline__ float wave_sum(float v) {
#pragma unroll
  for (int o = 1; o < 64; o <<= 1) v += __shfl_xor(v, o);
  return v;
}
__device__ __forceinline__ float siluf(float v) { return v * __builtin_amdgcn_rcpf(1.f + __expf(-v)); }
__device__ __forceinline__ int vi_now() { int bx = (int)blockIdx.x; asm volatile("" : "+s"(bx)); return (bx & 7) * 32 + (bx >> 3); }
__device__ __forceinline__ int tid_now() { int t = threadIdx.x; asm volatile("" : "+v"(t)); return t; }

__device__ __forceinline__ int colmap(int n) {
  const int pn = n >> 8, p = n & 255;
  if (pn <= 1) { const int e = p & 31, s = e >> 4, w = e & 15; return (n & ~31) + s * 16 + (w >> 1) + 8 * (w & 1); }
  if (pn == 4 || pn == 5) {
    const int bj = p >> 7, wc = (p >> 5) & 3, e = p & 31;
    if (pn == 4) return C_BQ + wc * 64 + bj * 32 + (e >> 1) + 16 * (e & 1);
    if (wc < 2) return C_BK + wc * 64 + bj * 32 + (e >> 1) + 16 * (e & 1);
    return C_BV + (wc - 2) * 64 + bj * 32 + e;
  }
  return n;
}
__device__ __forceinline__ float weff(const Params& P, int i, int k, int n) {
  const float* wrow = P.w_in + ((size_t)i * DM + k) * PINW;
  if (n < 3328) return wrow[colmap(n)];
  return ((float*)(P.ws + WS_WG))[((size_t)i * DM + k) * 256 + (n - 3328)];
}
__device__ __forceinline__ void p0_fold(const Params& P) {
  const int gt = blockIdx.x * NTHREADS + threadIdx.x, NG = gridDim.x * NTHREADS;
  for (int idx = gt; idx < DEPTH * DM * 256; idx += NG) {
    const int p = idx & 255, k = (idx >> 8) & 1023, i = idx >> 18, dir = p >> 7, j = p & 127;
    const float* w2 = (dir ? P.w2_b : P.w2_f) + (size_t)i * 16 * 128 + j;
    const float* r = P.w_in + ((size_t)i * DM + k) * PINW + 3328 + dir * 16;
    float s = 0.f;
#pragma unroll
    for (int q = 0; q < 16; ++q) s += r[q] * w2[q * 128];
    ((float*)(P.ws + WS_WG))[idx] = s;
  }
}

__device__ __forceinline__ void p0_mod(const Params& P, float* ldsf) {
  float* sc = ldsf;
  float* red = ldsf + 17 * 1024;
  const int tid = threadIdx.x;
  for (int u = blockIdx.x; u < 192; u += gridDim.x) {
    __syncthreads();
    for (int idx = tid; idx < 17 * 1024; idx += NTHREADS) { const int bb = idx >> 10, k = idx & 1023; const float c = bb < 16 ? P.c[bb * 1024 + k] : P.c_ctx[k]; sc[idx] = c / (1.f + expf(-c)); }
    __syncthreads();
    const int kc = tid >> 6, cl = tid & 63; const int cgl = u * 64 + cl; const int i = cgl / 3072, col = cgl % 3072;
    float acc[17];
#pragma unroll
    for (int bb = 0; bb < 17; ++bb) acc[bb] = 0.f;
    const float* w = P.ada_w + ((size_t)i * 1024 + kc * 128) * 3072 + col;
#pragma unroll 8
    for (int k = 0; k < 128; ++k) { const float wv = w[(size_t)k * 3072];
#pragma unroll
      for (int bb = 0; bb < 17; ++bb) acc[bb] += sc[bb * 1024 + kc * 128 + k] * wv; }
#pragma unroll
    for (int bb = 0; bb < 17; ++bb) red[(kc * 17 + bb) * 64 + cl] = acc[bb];
    __syncthreads();
    for (int idx = tid; idx < 17 * 64; idx += NTHREADS) { const int bb = idx >> 6, c2 = idx & 63; float s = 0.f;
#pragma unroll
      for (int q = 0; q < 8; ++q) s += red[(q * 17 + bb) * 64 + c2];
      const int cg2 = u * 64 + c2; const int i2 = cg2 / 3072, col2 = cg2 % 3072; ((float*)(P.ws + WS_MOD))[(size_t)(i2 * 17 + bb) * 3072 + col2] = s + P.ada_b[i2 * 3072 + col2]; }
  }
  __syncthreads();
}
__device__ __forceinline__ void p0_tables(const Params& P) {
  { const int gt = blockIdx.x * NTHREADS + threadIdx.x, NG = gridDim.x * NTHREADS; float* pv = (float*)(P.ws + WS_PV);
    for (int i = gt; i < PV_TOTAL; i += NG) { float v;
      if (i < PV_QN) v = P.subln_g[i]; else if (i < PV_KN) v = P.qn_g[i - PV_QN]; else if (i < PV_GLAG) v = P.kn_g[i - PV_KN]; else if (i < PV_LNG) v = P.gla_g[i - PV_GLAG];
      else if (i < PV_LNB) v = P.ln_g[i - PV_LNG]; else if (i < PV_SGB) v = P.ln_b[i - PV_LNB]; else if (i < PV_NORMG) v = P.sg_b[i - PV_SGB]; else v = P.norm_g[i - PV_NORMG];
      pv[i] = v; }
    bf16_t* sw = (bf16_t*)(P.ws + WS_SGW);
    for (int i = gt; i < DEPTH * 4 * 128 * 128 / 2; i += NG) { const float2 w = ((const float2*)P.sg_w)[i]; ((unsigned*)sw)[i] = pk2(w.x, w.y); } }
  if (blockIdx.x != gridDim.x - 1) return;
  const int tid = threadIdx.x;
  { const int pos = tid >> 3, j = tid & 7; const float inv = powf(10000.f, -(float)j / 8.f); const float a = (float)pos * inv; ((float*)(P.ws + WS_TAB))[T_COSA + tid] = cosf(a); ((float*)(P.ws + WS_TAB))[T_SINA + tid] = sinf(a); }
  for (int idx = tid; idx < 1024; idx += NTHREADS) { const int pos = idx >> 4, j = idx & 15; const float inv = powf(10000.f, -(float)j / 16.f); const float a = (float)pos * inv; ((float*)(P.ws + WS_TAB))[T_COSB + idx] = cosf(a); ((float*)(P.ws + WS_TAB))[T_SINB + idx] = sinf(a); }
  if (tid < 4) { float s1 = 0.f, s2 = 0.f; for (int d = 0; d < 32; ++d) { s1 += P.lq1[tid * 32 + d] * P.lk1[tid * 32 + d]; s2 += P.lq2[tid * 32 + d] * P.lk2[tid * 32 + d]; }
    const float li = (float)(0.8 - 0.6 * exp(-0.3 * (double)tid)); ((float*)(P.ws + WS_TAB))[T_LAM + tid] = expf(s1) - expf(s2) + li; ((float*)(P.ws + WS_TAB))[T_LAMI + tid] = li; }
}
template <int PART>
__device__ __forceinline__ void p0_weights(const Params& P, float* ldsf, int l0, int l1, int b0) {
  const int tid = tid_now(), lane = tid & 63, wave = tid >> 6;
  float* scr = ldsf + wave * (64 * 33);
  if ((int)blockIdx.x < b0) return;
  const int gw = ((int)blockIdx.x - b0) * 8 + wave, NGW = ((int)gridDim.x - b0) * 8;
  constexpr int I_IN = 16 * (NPROJ / 32), I_OUT = 16 * (DM / 32);
  const int NIT = (l1 - l0) * (I_IN + I_OUT);
  for (int it = gw; it < NIT; it += NGW) {
    const int i = l0 + it / (I_IN + I_OUT); int r = it % (I_IN + I_OUT);
    const bool isin = r < I_IN; if (!isin) r -= I_IN;
    const int nblk = isin ? NPROJ / 32 : DM / 32; const int kb = r / nblk, nb = r % nblk, k0 = 64 * kb, n0 = 32 * nb;
    if (PART != 2 && (isin && n0 >= 3328) != (PART == 1)) continue;
#pragma unroll 8
    for (int q = 0; q < 32; ++q) { const int kk = 2 * q + (lane >> 5), nn = lane & 31;
      scr[kk * 33 + nn] = isin ? weff(P, i, k0 + kk, n0 + nn) : P.w_out[((size_t)i * DM + k0 + kk) * DM + n0 + nn]; }
    asm volatile("s_waitcnt lgkmcnt(0)" ::: "memory");
    const int c = lane & 7;
    bf16_t* WT = isin ? ((bf16_t*)(P.ws + WS_WTIN)) + (size_t)i * NPROJ * DM : ((bf16_t*)(P.ws + WS_WTOUT)) + (size_t)i * DM * DM;
#pragma unroll
    for (int j = 0; j < 4; ++j) { const int n = (lane >> 3) + 8 * j; const float* s = scr + (8 * c) * 33 + n;
      u32x4 o; o.x = pk2(s[0 * 33], s[1 * 33]); o.y = pk2(s[2 * 33], s[3 * 33]); o.z = pk2(s[4 * 33], s[5 * 33]); o.w = pk2(s[6 * 33], s[7 * 33]);
      *(u32x4*)(WT + (size_t)(n0 + n) * DM + k0 + 8 * c) = o; }
    asm volatile("s_waitcnt lgkmcnt(0)" ::: "memory");
  }
}
__device__ __forceinline__ void p0_bias(const Params& P, float* ldsf, int l0, int l1, int b0) {
  float* sh = ldsf;
  float* red = ldsf + 17 * 1024;
  const int tid = tid_now();
  if ((int)blockIdx.x < b0) return;
  for (int u = (int)blockIdx.x - b0; u < (l1 - l0) * 56; u += (int)gridDim.x - b0) {
    const int i = l0 + u / 56, nb = u % 56;
    __syncthreads();
    for (int idx = tid; idx < 17 * 1024; idx += NTHREADS) { const int bb = idx >> 10, k = idx & 1023; sh[idx] = ((float*)(P.ws + WS_MOD))[(size_t)(i * 17 + bb) * 3072 + k]; }
    __syncthreads();
    const int kc = tid >> 6, cl = tid & 63; const int n = nb * 64 + cl;
    float acc[17];
#pragma unroll
    for (int bb = 0; bb < 17; ++bb) acc[bb] = 0.f;
#pragma unroll 8
    for (int k = 0; k < 128; ++k) { const float wv = weff(P, i, kc * 128 + k, n);
#pragma unroll
      for (int bb = 0; bb < 17; ++bb) acc[bb] += sh[bb * 1024 + kc * 128 + k] * wv; }
#pragma unroll
    for (int bb = 0; bb < 17; ++bb) red[(kc * 17 + bb) * 64 + cl] = acc[bb];
    __syncthreads();
    for (int idx = tid; idx < 17 * 64; idx += NTHREADS) { const int bb = idx >> 6, c2 = idx & 63; float s = 0.f;
#pragma unroll
      for (int q = 0; q < 8; ++q) s += red[(q * 17 + bb) * 64 + c2];
      const int n2 = nb * 64 + c2;
      if (n2 >= 3328) { const int p = n2 - 3328; s += (p >> 7) ? P.b_b[i * 128 + (p & 127)] : P.b_f[i * 128 + (p & 127)]; }
      ((float*)(P.ws + WS_BIAS))[(size_t)(i * 17 + bb) * NPROJ + n2] = s; }
  }
  __syncthreads();
}
__device__ __forceinline__ void p0_xs(const Params& P) {
  const int tid = threadIdx.x, lane = tid & 63, wave = tid >> 6;
  const int gw = blockIdx.x * 8 + wave, NGW = gridDim.x * 8;
  f32x4 g[4];
#pragma unroll
  for (int j = 0; j < 4; ++j) g[j] = *(const f32x4*)(P.norm_g + 4 * (lane + 64 * j));
  for (int row0 = gw * 2; row0 < MROWS; row0 += NGW * 2) {
    const float* src = row0 < NLAT ? P.x + (size_t)row0 * DM : P.ctx + (size_t)(row0 - NLAT) * DM;
    const int bb = row0 < NLAT ? (row0 >> 11) : 16;
    const float* sc = ((float*)(P.ws + WS_MOD)) + (size_t)bb * 3072 + 1024;
    f32x4 v[2][4], sv[4];
#pragma unroll
    for (int j = 0; j < 4; ++j) { const int k = 4 * (lane + 64 * j); sv[j] = *(const f32x4*)(sc + k); v[0][j] = __builtin_nontemporal_load((const f32x4*)(src + k)); v[1][j] = __builtin_nontemporal_load((const f32x4*)(src + DM + k)); }
#pragma unroll
    for (int r = 0; r < 2; ++r) { float ss = 0.f;
#pragma unroll
      for (int j = 0; j < 4; ++j) { const int k = 4 * (lane + 64 * j); const f32x4 x = v[r][j], gg = g[j], s = sv[j];
        ss += x.x * x.x + x.y * x.y + x.z * x.z + x.w * x.w;
        u32x2 o; o.x = pk2(x.x * gg.x * (1.f + s.x), x.y * gg.y * (1.f + s.y)); o.y = pk2(x.z * gg.z * (1.f + s.z), x.w * gg.w * (1.f + s.w));
        *(u32x2*)(((bf16_t*)(P.ws + WS_XS)) + (size_t)(row0 + r) * DM + k) = o; }
      ss = wave_sum(ss);
      if (lane < 16) ((float*)(P.ws + WS_SSP))[(size_t)(row0 + r) * 16 + lane] = lane == 0 ? ss : 0.f; }
  }
}

namespace pg8 {
#define PG8_LAS __attribute__((address_space(3)))
typedef unsigned short bf16_t;
typedef short bf16x8 __attribute__((ext_vector_type(8)));
typedef float f32x4 __attribute__((ext_vector_type(4)));
typedef unsigned u32x4 __attribute__((ext_vector_type(4)));
constexpr int BM = 256, BK = 64, HALF = 128, HTB = HALF * BK * 2  , STAGE_BYTES = 8 * HTB, NXCD = 8, WGM = 6;

__host__ __device__ __forceinline__ int lds_byte(int r, int c) { const int st = (r >> 4) * 2 + (c >> 5), rr = r & 15, cc = c & 31, ob = rr * 64 + cc * 2; return st * 1024 + (ob ^ (((ob >> 9) & 1) << 5)); }
__host__ __device__ __forceinline__ void stage_rc(int b, int& R, int& C) { const int st = b / 1024, sb = b % 1024, swz = sb ^ (((sb >> 9) & 1) << 5); R = (st >> 1) * 16 + swz / 64; C = (st & 1) * 32 + (swz % 64) / 2; }
__host__ __device__ __forceinline__ int perm32(int rho) { const int n = rho >> 4, i = rho & 15; return 8 * (i >> 2) + 4 * n + (i & 3); }

struct Unit { int pm, pn; };
struct Gemm { const bf16_t* A; const bf16_t* Bt; int M, N, K; };

struct StaticOrder {
    int nM, nN, nwg, G, c;
    __host__ __device__ void init(int M, int N, int G_, int c_) { nM = M / BM; nN = N / BM; nwg = nM * nN; G = G_; c = c_; }
    __host__ __device__ bool next(int i, Unit& u) const {
        const long L = (long)i * G + c; if (L >= nwg) return false;
        int wgid = (int)L; { const int q = nwg / NXCD, r = nwg % NXCD, xcd = wgid % NXCD, off = wgid / NXCD; wgid = (xcd < r ? xcd * (q + 1) : r * (q + 1) + (xcd - r) * q) + off; }
        const int nig = WGM * nN, gid = wgid / nig, fm = gid * WGM, gsz = (nM - fm) < WGM ? (nM - fm) : WGM;
        u.pm = fm + ((wgid % nig) % gsz); u.pn = (wgid % nig) / gsz; return true;
    }
    __device__ __forceinline__ void a_ready(const Unit&) const {}
    __device__ __forceinline__ void done(const Unit&) const {}
};
struct XcdOrder {
    int nMl, nN, G, c, rb0, cb0, nlat;
    __device__ __forceinline__ void init(int nMl_, int nN_, int G_, int c_, int rb0_, int cb0_, int nlat_) { nMl = nMl_; nN = nN_; G = G_; c = c_; rb0 = rb0_; cb0 = cb0_; nlat = nlat_; }
    __device__ __forceinline__ bool next(int i, Unit& u) const {
        const int L = i * G + c; if (L >= nMl * nN) return false;
        const int nig = WGM * nN, gid = L / nig, fm = gid * WGM, gsz = (nMl - fm) < WGM ? (nMl - fm) : WGM;
        const int pl = fm + ((L % nig) % gsz); u.pn = (L % nig) / gsz; u.pm = pl < nlat ? rb0 + pl : cb0 + (pl - nlat); return true;
    }
    __device__ __forceinline__ void a_ready(const Unit&) const {}
    __device__ __forceinline__ void done(const Unit&) const {}
};


template <class Epi, class Sched, bool ALIGN_EPI = false, bool SP2 = false>
__device__ __forceinline__ void gemm_phase(PG8_LAS unsigned char* lds, const Gemm g, const Sched& S, const Epi& E) {
    const int tid = tid_now(), wid = __builtin_amdgcn_readfirstlane(tid >> 6), lane = tid & 63, wr = wid >> 2, wc = wid & 3, fr = lane & 15, fq = lane >> 4;
    const int K = g.K, nt = K / BK;
    unsigned voffA[2], voffB[2];
#pragma unroll
    for (int i = 0; i < 2; ++i) { int R, C; stage_rc(tid * 16 + i * 8192, R, C); const int Rb = Epi::PERM ? ((R & ~31) + perm32(R & 31)) : R;
        voffA[i] = (unsigned)(R * K + C) * 2u; voffB[i] = (unsigned)(Rb * K + C) * 2u; }
    const size_t kstep = (size_t)(BK * 2);
    const size_t hstep = (size_t)HALF * K * 2;
    const size_t tstep = 2 * hstep;
    const unsigned ldsw = (unsigned)wid * 1024u;
    const int aoff = lds_byte(wr * 64 + fr, fq * 8), boff = lds_byte(wc * 32 + fr, fq * 8);
#define PG8_SA(b, h) (((b) * 2 + (h)) * HTB)
#define PG8_SB(b, h) ((4 + (b) * 2 + (h)) * HTB)
#define PG8_STAGE(bufoff, gbase, voff) do { _Pragma("unroll") for (int _i = 0; _i < 2; ++_i) \
        __builtin_amdgcn_global_load_lds((const unsigned*)((const char*)(gbase) + (voff)[_i]), (PG8_LAS unsigned*)(lds + (bufoff) + ldsw + _i * 8192), 16, 0, 0); } while (0)
#define PG8_LDA(dst, b, h) do { _Pragma("unroll") for (int m = 0; m < 4; ++m) _Pragma("unroll") for (int k = 0; k < 2; ++k) dst[m][k] = *(const PG8_LAS bf16x8*)(lds + PG8_SA(b, h) + aoff + m * 2048 + k * 1024); } while (0)
#define PG8_LDB(dst, b, h) do { _Pragma("unroll") for (int n = 0; n < 2; ++n) _Pragma("unroll") for (int k = 0; k < 2; ++k) dst[n][k] = *(const PG8_LAS bf16x8*)(lds + PG8_SB(b, h) + boff + n * 2048 + k * 1024); } while (0)
#define PG8_MMA(ai, bj, At, Bt) do { __builtin_amdgcn_s_setprio(1); _Pragma("unroll") for (int m = 0; m < 4; ++m) _Pragma("unroll") for (int n = 0; n < 2; ++n) _Pragma("unroll") for (int k = 0; k < 2; ++k) \
        acc[ai][bj][m][n] = __builtin_amdgcn_mfma_f32_16x16x32_bf16(Bt[n][k], At[m][k], acc[ai][bj][m][n], 0, 0, 0); __builtin_amdgcn_s_setprio(0); } while (0)
#define PG8_WAIT_V(n) asm volatile("s_waitcnt vmcnt(" #n ")" ::: "memory")
#define PG8_WAIT_L(n) asm volatile("s_waitcnt lgkmcnt(" #n ")" ::: "memory")
#define PG8_BAR __builtin_amdgcn_s_barrier()
#define PG8_SCHED __builtin_amdgcn_sched_barrier(0)
    Unit cur, nxt; int ui = 0;
    if (!S.next(0, cur)) return;
    f32x4 acc[2][2][4][2];
#pragma unroll
    for (int a = 0; a < 2; ++a)
#pragma unroll
        for (int b = 0; b < 2; ++b)
#pragma unroll
            for (int m = 0; m < 4; ++m)
#pragma unroll
                for (int n = 0; n < 2; ++n) acc[a][b][m][n] = (f32x4){0.f, 0.f, 0.f, 0.f};
    bf16x8 At[4][2], B0[2][2], B1[2][2];
    const char* cA = (const char*)g.A + (size_t)cur.pm * tstep; const char* cB = (const char*)g.Bt + (size_t)cur.pn * tstep;
    S.a_ready(cur);
    if constexpr (SP2) {
        PG8_STAGE(PG8_SB(0, 0), cB, voffB); PG8_STAGE(PG8_SB(0, 1), cB + hstep, voffB); PG8_STAGE(PG8_SA(0, 0), cA, voffA); PG8_STAGE(PG8_SA(0, 1), cA + hstep, voffA);
        if (wr == 1) PG8_BAR;
        PG8_WAIT_V(2); PG8_BAR;
        PG8_STAGE(PG8_SB(1, 0), cB + kstep, voffB); PG8_STAGE(PG8_SA(1, 0), cA + kstep, voffA); PG8_STAGE(PG8_SB(1, 1), cB + hstep + kstep, voffB);
        PG8_WAIT_V(6); PG8_BAR;
    } else {
        PG8_STAGE(PG8_SB(0, 0), cB, voffB); PG8_STAGE(PG8_SA(0, 0), cA, voffA); PG8_STAGE(PG8_SB(0, 1), cB + hstep, voffB); PG8_STAGE(PG8_SA(0, 1), cA + hstep, voffA);
        if (wr == 1) PG8_BAR;
        PG8_WAIT_V(4); PG8_BAR;
        PG8_STAGE(PG8_SB(1, 0), cB + kstep, voffB); PG8_STAGE(PG8_SA(1, 0), cA + kstep, voffA); PG8_STAGE(PG8_SB(1, 1), cB + hstep + kstep, voffB);
        PG8_WAIT_V(6); PG8_BAR;
    }
    for (;;) {
        const bool has_next = S.next(ui + 1, nxt);
        const char* nA = has_next ? (const char*)g.A + (size_t)nxt.pm * tstep : cA; const char* nB = has_next ? (const char*)g.Bt + (size_t)nxt.pn * tstep : cB;
        for (int t = 0; t < nt; t += 2) {
            const bool last = (t == nt - 2);
            const char* a1 = cA + (size_t)(t + 1) * kstep;
            const char* a2 = last ? nA : cA + (size_t)(t + 2) * kstep; const char* b2 = last ? nB : cB + (size_t)(t + 2) * kstep;
            const char* a3 = a2 + kstep; const char* b3 = b2 + kstep;
            if (last && has_next) S.a_ready(nxt);
            if constexpr (SP2) {
            PG8_LDB(B0, 0, 0); PG8_LDB(B1, 0, 1); PG8_SCHED; PG8_LDA(At, 0, 0); PG8_STAGE(PG8_SA(1, 1), a1 + hstep, voffA);
            PG8_WAIT_V(8); PG8_WAIT_L(0); PG8_BAR; PG8_MMA(0, 0, At, B0); PG8_MMA(0, 1, At, B1); PG8_BAR; PG8_SCHED;
            PG8_LDA(At, 0, 1); PG8_STAGE(PG8_SB(0, 0), b2, voffB); PG8_STAGE(PG8_SB(0, 1), b2 + hstep, voffB); PG8_STAGE(PG8_SA(0, 0), a2, voffA);
            PG8_WAIT_V(8); PG8_WAIT_L(0); PG8_BAR; PG8_MMA(1, 0, At, B0); PG8_MMA(1, 1, At, B1); PG8_BAR; PG8_SCHED;
            PG8_LDB(B0, 1, 0); PG8_LDB(B1, 1, 1); PG8_SCHED; PG8_LDA(At, 1, 0); PG8_STAGE(PG8_SA(0, 1), a2 + hstep, voffA);
            PG8_WAIT_V(8); PG8_WAIT_L(0); PG8_BAR; PG8_MMA(0, 0, At, B0); PG8_MMA(0, 1, At, B1); PG8_BAR; PG8_SCHED;
            PG8_LDA(At, 1, 1); PG8_STAGE(PG8_SB(1, 0), b3, voffB); PG8_STAGE(PG8_SB(1, 1), b3 + hstep, voffB); PG8_STAGE(PG8_SA(1, 0), a3, voffA);
            PG8_WAIT_V(8); PG8_WAIT_L(0); PG8_BAR; PG8_MMA(1, 0, At, B0); PG8_MMA(1, 1, At, B1); PG8_BAR; PG8_SCHED;
            } else {
            PG8_LDB(B0, 0, 0); PG8_SCHED; PG8_LDA(At, 0, 0); PG8_STAGE(PG8_SA(1, 1), a1 + hstep, voffA);
            PG8_WAIT_L(8); PG8_BAR; PG8_WAIT_L(0); PG8_MMA(0, 0, At, B0); PG8_BAR; PG8_SCHED;
            PG8_LDB(B1, 0, 1); PG8_STAGE(PG8_SB(0, 0), b2, voffB);
            PG8_BAR; PG8_WAIT_L(0); PG8_MMA(0, 1, At, B1); PG8_BAR;
            PG8_LDA(At, 0, 1); PG8_STAGE(PG8_SA(0, 0), a2, voffA);
            PG8_BAR; PG8_WAIT_L(0); PG8_MMA(1, 0, At, B0); PG8_BAR; PG8_SCHED;
            PG8_STAGE(PG8_SB(0, 1), b2 + hstep, voffB);
            PG8_WAIT_V(6); PG8_BAR; PG8_MMA(1, 1, At, B1); PG8_BAR;
            PG8_LDB(B0, 1, 0); PG8_SCHED; PG8_LDA(At, 1, 0); PG8_STAGE(PG8_SA(0, 1), a2 + hstep, voffA);
            PG8_WAIT_L(8); PG8_BAR; PG8_WAIT_L(0); PG8_MMA(0, 0, At, B0); PG8_BAR; PG8_SCHED;
            PG8_LDB(B1, 1, 1); PG8_STAGE(PG8_SB(1, 0), b3, voffB);
            PG8_BAR; PG8_WAIT_L(0); PG8_MMA(0, 1, At, B1); PG8_BAR;
            PG8_LDA(At, 1, 1); PG8_STAGE(PG8_SA(1, 0), a3, voffA);
            PG8_BAR; PG8_WAIT_L(0); PG8_MMA(1, 0, At, B0); PG8_BAR; PG8_SCHED;
            PG8_STAGE(PG8_SB(1, 1), b3 + hstep, voffB);
            PG8_WAIT_V(6); PG8_BAR; PG8_MMA(1, 1, At, B1); PG8_BAR;
            }
        }
        if constexpr (ALIGN_EPI) { if (wr == 0) PG8_BAR; }
        if constexpr (!Epi::AFTER_DRAIN) { E(acc, cur, ui, wr, wc, fr, fq); S.done(cur); }
        if (!has_next) break;
#pragma unroll
        for (int a = 0; a < 2; ++a)
#pragma unroll
            for (int b = 0; b < 2; ++b)
#pragma unroll
                for (int m = 0; m < 4; ++m)
#pragma unroll
                    for (int n = 0; n < 2; ++n) acc[a][b][m][n] = (f32x4){0.f, 0.f, 0.f, 0.f};
        cur = nxt; cA = nA; cB = nB; ++ui;
        if constexpr (ALIGN_EPI) { if (wr == 1) PG8_BAR; }
    }
    PG8_WAIT_V(0);
    if constexpr (!ALIGN_EPI) { if (wr == 0) PG8_BAR; }
    PG8_BAR;
    if constexpr (Epi::AFTER_DRAIN) { E.fused(acc, cur, wr, wc, fr, fq, lds, wid, lane); S.done(cur); }
#undef PG8_SA
#undef PG8_SB
#undef PG8_STAGE
#undef PG8_LDA
#undef PG8_LDB
#undef PG8_MMA
#undef PG8_WAIT_V
#undef PG8_WAIT_L
#undef PG8_BAR
#undef PG8_SCHED
}
}

__device__ __forceinline__ void rope4(f32x4& v, const f32x4 cs  ) {
  const float a0 = v.x * cs.x - v.y * cs.y, b0 = v.x * cs.y + v.y * cs.x, a1 = v.z * cs.z - v.w * cs.w, b1 = v.z * cs.w + v.w * cs.z;
  v = (f32x4){a0, b0, a1, b1};
}
__device__ __forceinline__ float logsig(float x) { return fminf(x, 0.f) - __logf(1.f + __expf(-fabsf(x))); }
struct EpiIn {
  const Params& P; int layer; const float* lrstd; const float* ltab; const float* lbias; const float* lqkn;
  static constexpr bool PERM = true, AFTER_DRAIN = false;
  __device__ __forceinline__ void operator()(const f32x4 (&acc)[2][2][4][2], const pg8::Unit& u, int ui, int wr, int wc, int fr, int fq) const { (*this)(acc, u.pm, u.pn, ui, wr, wc, fr, fq); }
  template <int KIND>
  __device__ __forceinline__ void rows(const f32x4 (&acc)[2][2][4][2], int pm, int pn, int ui, int wr, int wc, int fr, int fq) const {
    asm volatile("" : "+v"(fr), "+v"(fq));
    const bool lat = pm < 128; const int bb = lat ? (pm >> 3) : 16;
    const float* bias = lbias + ui * 256; (void)bb;
    const int cw = 32 * wc + 8 * fq;
    f32x4 bv[2][2];
#pragma unroll
    for (int bj = 0; bj < 2; ++bj)
#pragma unroll
      for (int n = 0; n < 2; ++n) bv[bj][n] = *(const f32x4*)(bias + 128 * bj + cw + 4 * n);
    const bool isnorm = KIND == 1 && ((pn == 4) || (wc < 2));
    const float* gsrc = lqkn + (pn == 4 ? 0 : 64);
#pragma unroll
    for (int ai = 0; ai < 2; ++ai)
#pragma unroll
      for (int m = 0; m < 4; ++m) {
        const int row = pm * 256 + 128 * ai + 64 * wr + 16 * m + fr;
        const float rstd = lrstd[ui * 256 + 128 * ai + 64 * wr + 16 * m + fr];
        f32x4 v[2][2];
#pragma unroll
        for (int bj = 0; bj < 2; ++bj)
#pragma unroll
          for (int n = 0; n < 2; ++n) v[bj][n] = acc[ai][bj][m][n] * rstd + bv[bj][n];
        const int t = row & 2047;
        bf16_t* prow = ((bf16_t*)(P.ws + WS_PROJ)) + (size_t)row * NPROJ;
        if (KIND == 0) {
          if (lat) { const int pos = (fq >> 1) == 0 ? (t >> 6) : (t & 63);
#pragma unroll
            for (int bj = 0; bj < 2; ++bj)
#pragma unroll
              for (int n = 0; n < 2; ++n) { const int j = 4 * (fq & 1) + 2 * n; const float* tc = ltab + T_COSA + pos * 8 + j; const float* ts = ltab + T_SINA + pos * 8 + j;
                rope4(v[bj][n], (f32x4){tc[0], ts[0], tc[1], ts[1]}); } }
          const float sc = pn == 0 ? 0.17677669529663687f * LOG2E : 1.f;
#pragma unroll
          for (int bj = 0; bj < 2; ++bj) { const f32x4 a = v[bj][0] * sc, b = v[bj][1] * sc;
            *(u32x4*)(prow + pn * 256 + 128 * bj + cw) = (u32x4){pk2(a.x, a.y), pk2(a.z, a.w), pk2(b.x, b.y), pk2(b.z, b.w)}; }
        } else if (KIND == 1) {
          if (isnorm) {
            float hs = 0.f;
#pragma unroll
            for (int bj = 0; bj < 2; ++bj)
#pragma unroll
              for (int n = 0; n < 2; ++n) hs += (v[bj][n].x * v[bj][n].x + v[bj][n].y * v[bj][n].y) + (v[bj][n].z * v[bj][n].z + v[bj][n].w * v[bj][n].w);
            hs += __shfl_xor(hs, 16); hs += __shfl_xor(hs, 32);
            const float hr = rsqrtf(hs * (1.f / 64.f) + EPS);
#pragma unroll
            for (int bj = 0; bj < 2; ++bj)
#pragma unroll
              for (int n = 0; n < 2; ++n) { const int j0 = bj * 32 + 4 * fq + 2 * n; v[bj][n] = v[bj][n] * hr * (f32x4){gsrc[j0], gsrc[j0 + 16], gsrc[j0 + 1], gsrc[j0 + 17]}; }
            if (lat) {
#pragma unroll
              for (int bj = 0; bj < 2; ++bj) { const int pos = bj == 0 ? (t >> 6) : (t & 63);
#pragma unroll
                for (int n = 0; n < 2; ++n) { const int j = 4 * fq + 2 * n; const float* tc = ltab + T_COSB + pos * 16 + j; const float* ts = ltab + T_SINB + pos * 16 + j;
                  rope4(v[bj][n], (f32x4){tc[0], ts[0], tc[1], ts[1]}); } } }
          }
          const float sc = pn == 4 ? 0.125f * LOG2E : 1.f;
          const int dbase = pn == 4 ? C_BQ + wc * 64 : (wc < 2 ? C_BK + wc * 64 : C_BV + (wc - 2) * 64);
#pragma unroll
          for (int bj = 0; bj < 2; ++bj) { const f32x4 a = v[bj][0] * sc, b = v[bj][1] * sc;
            *(u32x4*)(prow + dbase + bj * 32 + 8 * fq) = (u32x4){pk2(a.x, a.y), pk2(a.z, a.w), pk2(b.x, b.y), pk2(b.z, b.w)}; }
        } else if (KIND == 2) {
#pragma unroll
          for (int bj = 0; bj < 2; ++bj) { float* grow = ((float*)(P.ws + WS_GATE)) + (((size_t)((row >> 6) * 4 + wc) * 2 + bj) * 64 + (row & 63)) * 32 + 8 * fq;
#pragma unroll
            for (int n = 0; n < 2; ++n) { const f32x4 x = v[bj][n];
              *(f32x4*)(grow + 4 * n) = (f32x4){logsig(x.x) * 0.0625f, logsig(x.y) * 0.0625f, logsig(x.z) * 0.0625f, logsig(x.w) * 0.0625f}; } }
        } else {
          const bool sil = (pn == 3) || (pn == 6) || (pn == 9) || (pn == 12);
#pragma unroll
          for (int bj = 0; bj < 2; ++bj) { f32x4 a = v[bj][0], b = v[bj][1];
            if (sil) { a = (f32x4){siluf(a.x), siluf(a.y), siluf(a.z), siluf(a.w)}; b = (f32x4){siluf(b.x), siluf(b.y), siluf(b.z), siluf(b.w)}; }
            if (pn == 10 && bj == 0) { a = a * 0.17677669529663687f; b = b * 0.17677669529663687f; }
            *(u32x4*)(prow + pn * 256 + 128 * bj + cw) = (u32x4){pk2(a.x, a.y), pk2(a.z, a.w), pk2(b.x, b.y), pk2(b.z, b.w)}; }
        }
      }
  }
  __device__ __forceinline__ void operator()(const f32x4 (&acc)[2][2][4][2], int pm, int pn, int ui, int wr, int wc, int fr, int fq) const {
    if (pn <= 1) rows<0>(acc, pm, pn, ui, wr, wc, fr, fq);
    else if (pn == 4 || pn == 5) rows<1>(acc, pm, pn, ui, wr, wc, fr, fq);
    else if (pn == 13) rows<2>(acc, pm, pn, ui, wr, wc, fr, fq);
    else rows<3>(acc, pm, pn, ui, wr, wc, fr, fq);
  }
};
template <bool F32IN, bool F32OUT> struct EpiOut {
  const Params& P; int layer;
  static constexpr bool PERM = true, AFTER_DRAIN = false;
  __device__ __forceinline__ void operator()(const f32x4 (&acc)[2][2][4][2], const pg8::Unit& u, int ui, int wr, int wc, int fr, int fq) const { (*this)(acc, u.pm, u.pn, wr, wc, fr, fq); }
  __device__ __forceinline__ void operator()(const f32x4 (&acc)[2][2][4][2], int pm, int pn, int wr, int wc, int fr, int fq) const {
    asm volatile("" : "+v"(fr), "+v"(fq));
    const bool lat = pm < 128; const int bb = lat ? (pm >> 3) : 16;
    constexpr bool hn = !F32OUT;
    const float* gate = ((float*)(P.ws + WS_MOD)) + (size_t)(layer * 17 + bb) * 3072 + 2048 + pn * 256;
    const float* ng = PVEC(P) + PV_NORMG + (hn ? layer + 1 : layer) * DM + pn * 256;
    const float* nsc = ((float*)(P.ws + WS_MOD)) + (size_t)((hn ? layer + 1 : layer) * 17 + bb) * 3072 + 1024 + pn * 256;
    const int cw = 32 * wc + 8 * fq;
    f32x4 gv[2][2], cf[2][2];
#pragma unroll
    for (int bj = 0; bj < 2; ++bj)
#pragma unroll
      for (int n = 0; n < 2; ++n) { const int c0 = 128 * bj + cw + 4 * n; gv[bj][n] = *(const f32x4*)(gate + c0); if (hn) cf[bj][n] = *(const f32x4*)(ng + c0) * (*(const f32x4*)(nsc + c0) + 1.f); }
    const bf16_t* rb = lat ? (const bf16_t*)P.out + (size_t)(layer & 1) * NLAT * DM : (const bf16_t*)(P.ws + WS_XC) + (size_t)(layer & 1) * NCTX * DM;
    bf16_t* wb = lat ? (bf16_t*)P.out + (size_t)((layer + 1) & 1) * NLAT * DM : (bf16_t*)(P.ws + WS_XC) + (size_t)((layer + 1) & 1) * NCTX * DM;
    constexpr int RB = F32IN ? 2 : 4;
#pragma unroll
    for (int am = 0; am < 8 / RB; ++am) { const int ai = (am * RB) >> 2, mb = (am * RB) & 3;
      f32x4 xf[F32IN ? RB : 1][2][2]; u32x4 xh[F32IN ? 1 : RB][2];
#pragma unroll
      for (int mm = 0; mm < RB; ++mm) { const int row = pm * 256 + 128 * ai + 64 * wr + 16 * (mb + mm) + fr; const size_t rl = lat ? (size_t)row : (size_t)(row - NLAT);
        if (F32IN) { const float* xo = lat ? P.x + rl * DM : P.ctx + rl * DM;
#pragma unroll
          for (int bj = 0; bj < 2; ++bj)
#pragma unroll
            for (int n = 0; n < 2; ++n) xf[mm][bj][n] = __builtin_nontemporal_load((const f32x4*)(xo + pn * 256 + 128 * bj + cw + 4 * n)); }
        else {
#pragma unroll
          for (int bj = 0; bj < 2; ++bj) xh[mm][bj] = __builtin_nontemporal_load((const u32x4*)(rb + rl * DM + pn * 256 + 128 * bj + cw)); } }
#pragma unroll
      for (int mm = 0; mm < RB; ++mm) {
        const int m = mb + mm; const int row = pm * 256 + 128 * ai + 64 * wr + 16 * m + fr; const size_t rl = lat ? (size_t)row : (size_t)(row - NLAT);
        float ssq = 0.f;
#pragma unroll
        for (int bj = 0; bj < 2; ++bj) { f32x4 xn[2];
          if (F32IN) { xn[0] = xf[mm][bj][0]; xn[1] = xf[mm][bj][1]; }
          else { const u32x4 w = xh[mm][bj]; xn[0] = (f32x4){bflo(w.x), bfhi(w.x), bflo(w.y), bfhi(w.y)}; xn[1] = (f32x4){bflo(w.z), bfhi(w.z), bflo(w.w), bfhi(w.w)}; }
#pragma unroll
          for (int n = 0; n < 2; ++n) { xn[n] = xn[n] + gv[bj][n] * acc[ai][bj][m][n]; ssq += (xn[n].x * xn[n].x + xn[n].y * xn[n].y) + (xn[n].z * xn[n].z + xn[n].w * xn[n].w); }
          const int c = pn * 256 + 128 * bj + cw;
          if (F32OUT) { *(u32x4*)(((bf16_t*)(P.ws + WS_PROJ)) + (rl >> 12) * ((size_t)4096 * NPROJ) + (rl & 4095) * DM + c) = (u32x4){pk2(xn[0].x, xn[0].y), pk2(xn[0].z, xn[0].w), pk2(xn[1].x, xn[1].y), pk2(xn[1].z, xn[1].w)}; }
          else { *(u32x4*)(wb + rl * DM + c) = (u32x4){pk2(xn[0].x, xn[0].y), pk2(xn[0].z, xn[0].w), pk2(xn[1].x, xn[1].y), pk2(xn[1].z, xn[1].w)};
            const f32x4 a = xn[0] * cf[bj][0], b = xn[1] * cf[bj][1];
            *(u32x4*)(((bf16_t*)(P.ws + WS_XS)) + (size_t)row * DM + c) = (u32x4){pk2(a.x, a.y), pk2(a.z, a.w), pk2(b.x, b.y), pk2(b.z, b.w)}; } }
        ssq += __shfl_xor(ssq, 16); ssq += __shfl_xor(ssq, 32);
        if (fq == 0) ((float*)(P.ws + WS_SSP))[(size_t)row * 16 + pn * 4 + wc] = ssq;
      }
      asm volatile("" ::: "memory");
    }
  }
};

__device__ __forceinline__ void final_norm(const Params& P) {
  const int tid = tid_now(), lane = tid & 63, wave = tid >> 6;
  const bool aff = gridDim.x == 256;
  const int gw = aff ? (int)(blockIdx.x >> 3) * 8 + wave : (int)blockIdx.x * 8 + wave, NGW = aff ? 256 : (int)gridDim.x * 8;
  const int rbeg = aff ? (int)(blockIdx.x & 7) * 4096 : 0, rend = aff ? rbeg + 4096 : NLAT;
  f32x4 g[4];
#pragma unroll
  for (int j = 0; j < 4; ++j) g[j] = *(const f32x4*)(P.final_g + 4 * (lane + 64 * j));
  for (int row0 = rbeg + gw * 4; row0 < rend; row0 += NGW * 4) {
    u32x2 v[4][4]; float ss[4];
#pragma unroll
    for (int r = 0; r < 4; ++r) { ss[r] = lane < 16 ? ((float*)(P.ws + WS_SSP))[(size_t)(row0 + r) * 16 + lane] : 0.f;
#pragma unroll
      for (int j = 0; j < 4; ++j) v[r][j] = __builtin_nontemporal_load((const u32x2*)(((const bf16_t*)(P.ws + WS_PROJ)) + (size_t)((row0 + r) >> 12) * ((size_t)4096 * NPROJ) + (size_t)((row0 + r) & 4095) * DM + 4 * (lane + 64 * j))); }
#pragma unroll
    for (int r = 0; r < 4; ++r) { const float rstd = rsqrtf(wave_sum(ss[r]) * (1.f / DM) + EPS);
#pragma unroll
      for (int j = 0; j < 4; ++j) { const f32x4 x = {bflo(v[r][j].x), bfhi(v[r][j].x), bflo(v[r][j].y), bfhi(v[r][j].y)}; __builtin_nontemporal_store(x * rstd * g[j], (f32x4*)(P.out + (size_t)(row0 + r) * DM + 4 * (lane + 64 * j))); } }
  }
}
namespace att {
using bf16x8=__attribute__((ext_vector_type(8)))short;
using s16x4=__attribute__((ext_vector_type(4)))short;
using f32x16=__attribute__((ext_vector_type(16)))float;
constexpr int NW=8,QBLK=32,QB=QBLK*NW,KVBLK=64,PITCH=NPROJ;
__device__ __forceinline__ int crow(int r,int hi){return (r&3)+8*(r>>2)+4*hi;}
#define SBAR() __builtin_amdgcn_sched_barrier(0)
constexpr int NSLOT=3, SLOTB=8192;
constexpr int LDS_K=0, LDS_V=NSLOT*SLOTB, LDS_WS=2*NSLOT*SLOTB, LDS_OST=LDS_WS+NW*64*4, LDS_BYTES_ATT=LDS_OST+NW*8192;
__device__ __forceinline__ void glds16(const void*gsrc,unsigned lds_dst){unsigned keep;
  asm volatile("s_mov_b32 %0, m0\n\ts_mov_b32 m0, %2\n\ts_nop 0\n\tglobal_load_lds_dwordx4 %1, off\n\ts_mov_b32 m0, %0":"=&s"(keep):"v"(gsrc),"s"(lds_dst):"memory");}
__device__ __forceinline__ float max3f(float a,float b,float c){float r;asm("v_max3_f32 %0, %1, %2, %3":"=v"(r):"v"(a),"v"(b),"v"(c));return r;}
__device__ __forceinline__ float max2f(float a,float b){float r;asm("v_max_f32_e32 %0, %1, %2":"=v"(r):"v"(a),"v"(b));return r;}
__device__ __forceinline__ float fadd_s(float a,float b){float r;asm("v_add_f32_e32 %0, %1, %2":"=v"(r):"v"(a),"v"(b));return r;}
__device__ __forceinline__ float fsub_s(float a,float b){float r;asm("v_sub_f32_e32 %0, %1, %2":"=v"(r):"v"(a),"v"(b));return r;}
typedef float f32x2_t __attribute__((ext_vector_type(2))); typedef __bf16 bf16x2_t __attribute__((ext_vector_type(2)));
__device__ __forceinline__ unsigned cvtpk_s(float lo,float hi){f32x2_t v={lo,hi};bf16x2_t b=__builtin_convertvector(v,bf16x2_t);return __builtin_bit_cast(unsigned,b);}
#define WAIT_BAR(N) asm volatile("s_waitcnt vmcnt(" #N ") lgkmcnt(0)\n\ts_barrier":::"memory")
template<int ND> __device__ __forceinline__ void qkt(f32x16&p0,f32x16&p1,const char*Kslot,const bf16x8*qr,const f32x16&negm,int r32,int hi){
  const char*kb=Kslot+hi*1024+r32*16;
  #pragma unroll
  for(int d0=0;d0<ND;++d0){
    const bf16x8 b0=*reinterpret_cast<const bf16x8*>(kb+d0*2048);
    const bf16x8 b1=*reinterpret_cast<const bf16x8*>(kb+d0*2048+512);
    if(d0==0){p0=__builtin_amdgcn_mfma_f32_32x32x16_bf16(b0,qr[0],negm,0,0,0);p1=__builtin_amdgcn_mfma_f32_32x32x16_bf16(b1,qr[0],negm,0,0,0);}
    else{p0=__builtin_amdgcn_mfma_f32_32x32x16_bf16(b0,qr[d0],p0,0,0,0);p1=__builtin_amdgcn_mfma_f32_32x32x16_bf16(b1,qr[d0],p1,0,0,0);}}
}
typedef __attribute__((address_space(3))) const char* lds_cptr;
typedef short v4i16_t __attribute__((ext_vector_type(4)));
__device__ __forceinline__ void kload8(bf16x8*kf,lds_cptr kp){
  kf[0]=*(const __attribute__((address_space(3))) bf16x8*)(kp);      kf[1]=*(const __attribute__((address_space(3))) bf16x8*)(kp+512);
  kf[2]=*(const __attribute__((address_space(3))) bf16x8*)(kp+2048); kf[3]=*(const __attribute__((address_space(3))) bf16x8*)(kp+2560);
  kf[4]=*(const __attribute__((address_space(3))) bf16x8*)(kp+4096); kf[5]=*(const __attribute__((address_space(3))) bf16x8*)(kp+4608);
  kf[6]=*(const __attribute__((address_space(3))) bf16x8*)(kp+6144); kf[7]=*(const __attribute__((address_space(3))) bf16x8*)(kp+6656);
}
__device__ __forceinline__ void kload2(bf16x8*kf,lds_cptr kp,int j){ kf[2*j]=*(const __attribute__((address_space(3))) bf16x8*)(kp+j*2048); kf[2*j+1]=*(const __attribute__((address_space(3))) bf16x8*)(kp+j*2048+512); }
__device__ __forceinline__ s16x4 vtr(lds_cptr p){ return __builtin_bit_cast(s16x4,__builtin_amdgcn_ds_read_tr16_b64_v4i16((__attribute__((address_space(3))) v4i16_t*)p)); }
__device__ __forceinline__ float rowmax(const f32x16&p0,const f32x16&p1){
  float a=max3f(p0[0],p0[1],p1[0]),b=max3f(p0[2],p0[3],p1[1]);a=max3f(a,p1[2],p1[3]);
  #pragma unroll
  for(int r=4;r<16;r+=4){a=max3f(a,p0[r],p0[r+1]);b=max3f(b,p0[r+2],p0[r+3]);a=max3f(a,p1[r],p1[r+1]);b=max3f(b,p1[r+2],p1[r+3]);}
  const float m=max2f(a,b);
  auto rr=__builtin_amdgcn_permlane32_swap(__float_as_uint(m),__float_as_uint(m),false,false);
  return max2f(__uint_as_float(rr[0]),__uint_as_float(rr[1]));
}
__device__ __forceinline__ void pv(f32x16*o,int vb,bf16x8 pa0,bf16x8 pa1,bf16x8 pa2,bf16x8 pa3){
  #pragma unroll
  for(int d0=0;d0<2;++d0){s16x4 lo[4],hi[4];
    #pragma unroll
    for(int ks=0;ks<4;++ks){
      asm volatile("ds_read_b64_tr_b16 %0,%1 offset:%c2":"=&v"(lo[ks]):"v"(vb),"i"(d0*4096+ks*1024):"memory");
      asm volatile("ds_read_b64_tr_b16 %0,%1 offset:%c2":"=&v"(hi[ks]):"v"(vb),"i"(d0*4096+ks*1024+512):"memory");}
    asm volatile("s_waitcnt lgkmcnt(0)":::"memory");SBAR();
    #define PK(k) (bf16x8){lo[k][0],lo[k][1],lo[k][2],lo[k][3],hi[k][0],hi[k][1],hi[k][2],hi[k][3]}
    o[d0]=__builtin_amdgcn_mfma_f32_32x32x16_bf16(pa0,PK(0),o[d0],0,0,0);
    o[d0]=__builtin_amdgcn_mfma_f32_32x32x16_bf16(pa1,PK(1),o[d0],0,0,0);
    o[d0]=__builtin_amdgcn_mfma_f32_32x32x16_bf16(pa2,PK(2),o[d0],0,0,0);
    o[d0]=__builtin_amdgcn_mfma_f32_32x32x16_bf16(pa3,PK(3),o[d0],0,0,0);
    #undef PK
  }
}
template<int TYPE,int THRL> __device__ __forceinline__ void attn_unit(const Params&P,int layer,int b,int h,int qb,char*shm,bool pre=false,int nxt=-1){
  const int tid=tid_now(),lane=tid&63,r32=lane&31,hi=lane>>5; const int wid=__builtin_amdgcn_readfirstlane(tid>>6);
  const bool isctx=(qb==8);
  const int crow0=NLAT+b*CTXL, lrow0=b*SEQ;
  const int q0=isctx?crow0:lrow0+qb*QB;
  const int NT=isctx?4:36;
  const int qcol=TYPE==0?C_AQ+h*64:C_BQ+h*64, kcol=TYPE==0?C_AK+h*64:C_BK+(h>>1)*64, vcol=TYPE==0?C_AV+h*64:C_BV+(h>>1)*64;
  const bf16_t*Qw=((bf16_t*)(P.ws + WS_PROJ))+(size_t)(q0+wid*QBLK)*PITCH+qcol;
  const unsigned lds0=(unsigned)(uintptr_t)shm;
  float*wsf=(float*)(shm+LDS_WS)+wid*64;
  const bf16_t*ksrc=((bf16_t*)(P.ws + WS_PROJ))+(long)lane*PITCH+kcol+wid*8;
  const bf16_t*vsrc=((bf16_t*)(P.ws + WS_PROJ))+(long)(16*(wid&3)+(lane>>2))*PITCH+vcol+(wid>>2)*32+(lane&3)*8;
  const unsigned kdst=lds0+LDS_K+wid*1024, vdst=lds0+LDS_V+wid*1024;
  #define TROW(t) ((long)((t)<4?crow0+(t)*KVBLK:lrow0+((t)-4)*KVBLK)*PITCH)
  #define DMA_K(t,slot) glds16(ksrc+TROW(t),(unsigned)__builtin_amdgcn_readfirstlane(kdst+(slot)))
  #define DMA_V(t,slot) glds16(vsrc+TROW(t),(unsigned)__builtin_amdgcn_readfirstlane(vdst+(slot)))
  const int vb0=(int)(lds0+LDS_V)+((lane>>4)&1)*32+(lane&3)*8+(4*hi+((lane&15)>>2))*64;
  const char*Kbase=shm+LDS_K; bf16x8 kf[8];
  const lds_cptr shm3=(lds_cptr)shm; const lds_cptr kp0=shm3+LDS_K+hi*1024+r32*16; const lds_cptr vp0=shm3+LDS_V+((lane>>4)&1)*32+(lane&3)*8+(4*hi+((lane&15)>>2))*64;
  float*stgf=(float*)(shm+LDS_OST)+wid*2048;
  for(int pass=0;pass<(TYPE==0?2:1);++pass){
  if(!(pre&&pass==0)&&!(TYPE==0&&pass==1)){DMA_K(0,0);DMA_V(0,0);DMA_K(1,SLOTB);}
  bf16x8 qr[4];
  #pragma unroll
  for(int d0=0;d0<(TYPE==0?2:4);++d0)qr[d0]=*reinterpret_cast<const bf16x8*>(&Qw[(long)r32*PITCH+((TYPE==0?2*pass:0)+d0)*16+hi*8]);
  if(TYPE==0){qr[2]=qr[0];qr[3]=qr[1];}
  const int koff=TYPE==0?pass*4096:0; const lds_cptr kpp=kp0+koff;
  float mhat=0.f,l_reg=0.f;f32x16 o[2];o[0]=f32x16{};o[1]=f32x16{};f32x16 negm=f32x16{};asm volatile("":"+v"(negm));
  bool resc=false;
  #define START(P0,P1) do{ const float rm=rowmax(P0,P1); resc=false; \
    { const float dl=rm; mhat=fadd_s(mhat,dl); \
      _Pragma("unroll") for(int r=0;r<16;++r){P0[r]=fsub_s(P0[r],dl);P1[r]=fsub_s(P1[r],dl);} \
      _Pragma("unroll") for(int r=0;r<16;++r)negm[r]=-mhat; asm volatile("":"+v"(negm)); } \
    _Pragma("unroll") for(int r=0;r<16;++r)P0[r]=__builtin_amdgcn_exp2f(P0[r]); }while(0)
  #define RESC() do{ if(resc){ asm volatile("s_waitcnt lgkmcnt(0)":::"memory"); \
      _Pragma("unroll") for(int d_=0;d_<2;++d_) _Pragma("unroll") for(int r=0;r<16;++r)o[d_][r]*=wsf[crow(r,hi)]; } }while(0)
  f32x16 pA0,pA1,pB0,pB1;
  int sl_prev=0,sl_cur=0,sl_next=SLOTB;
  #define ROT() do{sl_prev=sl_cur;sl_cur=sl_next;sl_next=(sl_next==(NSLOT-1)*SLOTB)?0:sl_next+SLOTB;}while(0)
  DMA_K(2,2*SLOTB);
  WAIT_BAR(3);
  qkt<(TYPE==0?2:4)>(pA0,pA1,Kbase+koff,qr,negm,r32,hi);asm volatile("s_nop 15\n\ts_nop 7":"+v"(pA0),"+v"(pA1));
  START(pA0,pA1);
  _Pragma("unroll") for(int r=0;r<16;++r)pA1[r]=__builtin_amdgcn_exp2f(pA1[r]);
  WAIT_BAR(0);
  DMA_K(3,0);DMA_V(1,SLOTB);
  ROT();
  if(TYPE==0){kload2(kf,kpp+sl_cur,0);kload2(kf,kpp+sl_cur,1);}else kload8(kf,kp0+sl_cur);
  WAIT_BAR(2);
  s16x4 vlo[8],vhi[8]; u32x4 pw0,pw1,pw2,pw3;
  #define PKW(P,B) cvtpk_s(P[B],P[B+1])
  #define PAF(k) __builtin_bit_cast(bf16x8,pw##k)
  #define VFR(i) (bf16x8){vlo[i][0],vlo[i][1],vlo[i][2],vlo[i][3],vhi[i][0],vhi[i][1],vhi[i][2],vhi[i][3]}
  #define PIN(x) asm volatile("":"+v"(x))
  #define MX3(a,b,c) __builtin_fmaxf(__builtin_fmaxf((a),(b)),(c))
  #define GAPA(MF,A0,A1,A2,A3,W0,W1,PW) do{ MF; sacc+=A0; sacc+=A1; sacc+=A2; sacc+=A3; PIN(sacc); W0; W1; PIN(PW); SBAR(); }while(0)
  #define EX(v) __builtin_amdgcn_exp2f(v)
  #define GAPB(MF,X,B) do{ MF; X[B]=EX(X[B]); X[B+1]=EX(X[B+1]); X[B+2]=EX(X[B+2]); X[B+3]=EX(X[B+3]); PIN(X); SBAR(); }while(0)
  #define VRD(i) do{ vlo[i]=vtr(vp_+(((i)>>2)*4096+((i)&3)*1024)); vhi[i]=vtr(vp_+(((i)>>2)*4096+((i)&3)*1024+512)); }while(0)
  #define KRD(G,j) do{ if((G)&&(TYPE!=0||(j)<2)){ kload2(kf,kpp+sl_next,j); SBAR(); } }while(0)
  #define STEP(C0,C1,P0,P1,t,GK,GV,GL) do{ SBAR(); \
    const lds_cptr vp_=vp0+sl_prev; \
    VRD(0); SBAR(); float sacc=(P0[0]+P0[1]); \
    GAPA(C0=__builtin_amdgcn_mfma_f32_32x32x16_bf16(kf[0],qr[0],negm,0,0,0), P0[2],P0[3],P0[4],P0[5],     pw0[0]=PKW(P0,0), pw0[1]=PKW(P0,2), pw0); \
    VRD(4); SBAR(); GAPA(C1=__builtin_amdgcn_mfma_f32_32x32x16_bf16(kf[1],qr[0],negm,0,0,0), P0[6],P0[7],P0[8],P0[9],     pw0[2]=PKW(P0,4), pw0[3]=PKW(P0,6), pw0); \
    VRD(1); SBAR(); GAPA(C0=__builtin_amdgcn_mfma_f32_32x32x16_bf16(kf[2],qr[1],C0,0,0,0),   P0[10],P0[11],P0[12],P0[13], pw1[0]=PKW(P0,8), pw1[1]=PKW(P0,10), pw1); \
    VRD(5); SBAR(); GAPA(C1=__builtin_amdgcn_mfma_f32_32x32x16_bf16(kf[3],qr[1],C1,0,0,0),   P0[14],P0[15],P1[0],P1[1],   pw1[2]=PKW(P0,12),pw1[3]=PKW(P0,14), pw1); \
    VRD(2); SBAR(); GAPA(if(TYPE!=0)C0=__builtin_amdgcn_mfma_f32_32x32x16_bf16(kf[4],qr[2],C0,0,0,0),   P1[2],P1[3],P1[4],P1[5],     pw2[0]=PKW(P1,0), pw2[1]=PKW(P1,2), pw2); \
    VRD(6); SBAR(); GAPA(if(TYPE!=0)C1=__builtin_amdgcn_mfma_f32_32x32x16_bf16(kf[5],qr[2],C1,0,0,0),   P1[6],P1[7],P1[8],P1[9],     pw2[2]=PKW(P1,4), pw2[3]=PKW(P1,6), pw2); \
    VRD(3); SBAR(); GAPA(if(TYPE!=0)C0=__builtin_amdgcn_mfma_f32_32x32x16_bf16(kf[6],qr[3],C0,0,0,0),   P1[10],P1[11],P1[12],P1[13], pw3[0]=PKW(P1,8), pw3[1]=PKW(P1,10), pw3); \
    VRD(7); SBAR(); GAPA(if(TYPE!=0)C1=__builtin_amdgcn_mfma_f32_32x32x16_bf16(kf[7],qr[3],C1,0,0,0),   P1[14],P1[15],0.f,0.f,       pw3[2]=PKW(P1,12),pw3[3]=PKW(P1,14), pw3); \
    l_reg+=sacc; \
    if(GK){DMA_K((t)+3,sl_cur);} if(GV){DMA_V((t)+1,sl_next);} \
    { float a=MX3(C0[0],C0[1],C1[0]),b=MX3(C0[2],C0[3],C1[1]); a=MX3(a,C1[2],C1[3]); \
      _Pragma("unroll") for(int r=4;r<16;r+=4){a=MX3(a,C0[r],C0[r+1]);b=MX3(b,C0[r+2],C0[r+3]);a=MX3(a,C1[r],C1[r+1]);b=MX3(b,C1[r+2],C1[r+3]);} \
      float rm=__builtin_fmaxf(a,b); { auto rr=__builtin_amdgcn_permlane32_swap(__float_as_uint(rm),__float_as_uint(rm),false,false); rm=__builtin_fmaxf(__uint_as_float(rr[0]),__uint_as_float(rr[1])); } \
      resc=false; \
      if(__builtin_expect(__any(rm>(float)THRL),0)){ const float dl=__builtin_fmaxf(rm,0.f); mhat+=dl; \
        _Pragma("unroll") for(int r=0;r<16;++r){C0[r]-=dl;C1[r]-=dl;} \
        _Pragma("unroll") for(int r=0;r<16;++r)negm[r]=-mhat; asm volatile("":"+v"(negm)); \
        const float f=__builtin_amdgcn_exp2f(-dl); l_reg*=f; if(hi==0)wsf[r32]=f; resc=true; } } \
    SBAR(); \
    GAPB(o[0]=__builtin_amdgcn_mfma_f32_32x32x16_bf16(PAF(0),VFR(0),o[0],0,0,0), C0,0); \
    GAPB(o[1]=__builtin_amdgcn_mfma_f32_32x32x16_bf16(PAF(0),VFR(4),o[1],0,0,0), C0,4); \
    KRD(GL,0); GAPB(o[0]=__builtin_amdgcn_mfma_f32_32x32x16_bf16(PAF(1),VFR(1),o[0],0,0,0), C0,8); \
    KRD(GL,1); GAPB(o[1]=__builtin_amdgcn_mfma_f32_32x32x16_bf16(PAF(1),VFR(5),o[1],0,0,0), C0,12); \
    KRD(GL,2); GAPB(o[0]=__builtin_amdgcn_mfma_f32_32x32x16_bf16(PAF(2),VFR(2),o[0],0,0,0), C1,0); \
    KRD(GL,3); GAPB(o[1]=__builtin_amdgcn_mfma_f32_32x32x16_bf16(PAF(2),VFR(6),o[1],0,0,0), C1,4); \
    GAPB(o[0]=__builtin_amdgcn_mfma_f32_32x32x16_bf16(PAF(3),VFR(3),o[0],0,0,0), C1,8); \
    GAPB(o[1]=__builtin_amdgcn_mfma_f32_32x32x16_bf16(PAF(3),VFR(7),o[1],0,0,0), C1,12); \
    }while(0)
  int t=1;
  for(;t+5<NT;t+=2){
    STEP(pB0,pB1,pA0,pA1,t,true,true,true);     WAIT_BAR(2); RESC(); ROT();
    STEP(pA0,pA1,pB0,pB1,t+1,true,true,true);   WAIT_BAR(2); RESC(); ROT();
  }
  #define ENDW(tt) do{ if((tt)+3<NT){WAIT_BAR(2);} else if((tt)+2<NT){WAIT_BAR(1);} else {WAIT_BAR(0);} }while(0)
  for(;t+1<NT;t+=2){
    STEP(pB0,pB1,pA0,pA1,t,(t+3<NT),(t+1<NT),(t+1<NT));       ENDW(t);   RESC(); ROT();
    STEP(pA0,pA1,pB0,pB1,t+1,(t+4<NT),(t+2<NT),(t+2<NT));     ENDW(t+1); RESC(); ROT();
  }
  STEP(pB0,pB1,pA0,pA1,NT-1,false,false,false); RESC();
  { float sacc=pB0[0]+pB0[1]; _Pragma("unroll") for(int r=2;r<16;++r)sacc+=pB0[r]; _Pragma("unroll") for(int r=0;r<16;++r)sacc+=pB1[r]; l_reg+=sacc;
    pw0=(u32x4){PKW(pB0,0),PKW(pB0,2),PKW(pB0,4),PKW(pB0,6)};pw1=(u32x4){PKW(pB0,8),PKW(pB0,10),PKW(pB0,12),PKW(pB0,14)};pw2=(u32x4){PKW(pB1,0),PKW(pB1,2),PKW(pB1,4),PKW(pB1,6)};pw3=(u32x4){PKW(pB1,8),PKW(pB1,10),PKW(pB1,12),PKW(pB1,14)};
    SBAR(); pv(o,vb0+sl_cur,PAF(0),PAF(1),PAF(2),PAF(3)); }
  #undef PKW
  #undef PAF
  #undef VFR
  #undef PIN
  #undef MX3
  #undef GAPA
  #undef GAPB
  #undef EX
  #undef VRD
  #undef KRD
  #undef STEP
  #undef ENDW
  asm volatile("s_waitcnt lgkmcnt(0)\n\ts_barrier":::"memory");
  if(TYPE==0&&pass==0){DMA_K(0,0);DMA_V(0,0);DMA_K(1,SLOTB);}
  else if(nxt>=0){ const int nt_=nxt>>12,nb_=(nxt>>4)&15,nh_=nxt&3; const int nk_=nt_==0?C_AK+nh_*64:C_BK+(nh_>>1)*64, nv_=nt_==0?C_AV+nh_*64:C_BV+(nh_>>1)*64;
    const bf16_t*nks=((bf16_t*)(P.ws + WS_PROJ))+(long)lane*PITCH+nk_+wid*8+(long)(NLAT+nb_*CTXL)*PITCH;
    const bf16_t*nvs=((bf16_t*)(P.ws + WS_PROJ))+(long)(16*(wid&3)+(lane>>2))*PITCH+nv_+(wid>>2)*32+(lane&3)*8+(long)(NLAT+nb_*CTXL)*PITCH;
    glds16(nks,(unsigned)__builtin_amdgcn_readfirstlane(kdst)); glds16(nvs,(unsigned)__builtin_amdgcn_readfirstlane(vdst)); glds16(nks+(long)KVBLK*PITCH,(unsigned)__builtin_amdgcn_readfirstlane(kdst+SLOTB)); }
  {auto rr=__builtin_amdgcn_permlane32_swap(__float_as_uint(l_reg),__float_as_uint(l_reg),false,false);l_reg=__uint_as_float(rr[0])+__uint_as_float(rr[1]);}
  if(hi==0)wsf[32+r32]=l_reg;asm volatile("s_waitcnt lgkmcnt(0)":::"memory");
  float rli[16];
  #pragma unroll
  for(int r=0;r<16;++r)rli[r]=__builtin_amdgcn_rcpf(wsf[32+crow(r,hi)]);
  if(TYPE==0&&pass==0){
    #pragma unroll
    for(int d0=0;d0<2;++d0)
      #pragma unroll
      for(int r=0;r<16;++r)stgf[(d0*16+r)*64+lane]=o[d0][r]*rli[r];
    continue;
  }
  if(TYPE==0){ const float lam=((float*)(P.ws + WS_TAB))[T_LAM+layer];
    #pragma unroll
    for(int d0=0;d0<2;++d0)
      #pragma unroll
      for(int r=0;r<16;++r)o[d0][r]=stgf[(d0*16+r)*64+lane]-lam*(o[d0][r]*rli[r]);
    asm volatile("s_waitcnt lgkmcnt(0)":::"memory");
  } else {
    #pragma unroll
    for(int d0=0;d0<2;++d0)
      #pragma unroll
      for(int r=0;r<16;++r)o[d0][r]*=rli[r];
  }
  asm volatile("":"+v"(o[0]),"+v"(o[1])::"memory");
  #pragma unroll
  for(int r=0;r<16;++r){const int orow=crow(r,hi);
    #pragma unroll
    for(int d0=0;d0<2;++d0)stgf[orow*64+d0*32+r32]=o[d0][r];}
  asm volatile("s_waitcnt lgkmcnt(0)":::"memory");
  { const float post=TYPE==0?(1.f-((float*)(P.ws + WS_TAB))[T_LAMI+layer]):1.f; const float*sg=PVEC(P)+PV_SUBLN+layer*64;
    #pragma unroll
    for(int ih=0;ih<2;++ih){
    u32x4 zws[2];
    #pragma unroll
    for(int i=0;i<2;++i){const size_t grow=(size_t)(q0+wid*QBLK+(2*ih+i)*8+(lane>>3)); zws[i]=*(const u32x4*)(((bf16_t*)(P.ws + WS_PROJ))+grow*PITCH+(TYPE==0?C_AZ:C_BZ)+h*64+(lane&7)*8);}
    #pragma unroll
    for(int i2=0;i2<2;++i2){const int i=2*ih+i2; const int row=i*8+(lane>>3),ch=lane&7; const f32x4 v0=*(const f32x4*)(stgf+row*64+ch*8), v1=*(const f32x4*)(stgf+row*64+ch*8+4);
      const size_t grow=(size_t)(q0+wid*QBLK+row);
      const u32x4 zw=zws[i2];
      f32x4 a=v0,c=v1;
      if(TYPE==0){ float ss=(v0.x*v0.x+v0.y*v0.y)+(v0.z*v0.z+v0.w*v0.w)+(v1.x*v1.x+v1.y*v1.y)+(v1.z*v1.z+v1.w*v1.w);
        ss+=__shfl_xor(ss,1);ss+=__shfl_xor(ss,2);ss+=__shfl_xor(ss,4);
        const float rs=rsqrtf(ss*(1.f/64.f)+EPS)*post; a=a*rs*(*(const f32x4*)(sg+ch*8)); c=c*rs*(*(const f32x4*)(sg+ch*8+4)); }
      const u32x4 w={pk2(a.x*bflo(zw.x),a.y*bfhi(zw.x)),pk2(a.z*bflo(zw.y),a.w*bfhi(zw.y)),pk2(c.x*bflo(zw.z),c.y*bfhi(zw.z)),pk2(c.z*bflo(zw.w),c.w*bfhi(zw.w))};
      *(u32x4*)(((bf16_t*)(P.ws + WS_Y))+grow*DM+(TYPE==0?0:256)+h*64+ch*8)=w; } } }
  }
  #undef DMA_K
  #undef DMA_V
  #undef TROW
  #undef START
  #undef RESC
  #undef ROT
}
#undef SBAR
#undef WAIT_BAR
}
__device__ __forceinline__ bf16_t* of_row(const Params& P, int dir, int row) {
  const bool lat = row < NLAT; const int c = row - NLAT; const int x = lat ? (row >> 12) : (c >> 9), lr = lat ? (row & 4095) : 4096 + (c & 511);
  return ((bf16_t*)(P.ws + WS_XS)) + (size_t)x * (4096 * 1024) + ((size_t)dir * 4608 + lr) * 256;
}
namespace gla {
typedef short bf16x8 __attribute__((ext_vector_type(8)));
typedef float f32x16 __attribute__((ext_vector_type(16)));
__device__ __forceinline__ int crow(int r, int hi) { return (r & 3) + 8 * (r >> 2) + 4 * hi; }
constexpr int GRP_BYTES = 62464;
__device__ __forceinline__ size_t gblk(int chunk, int h, int dir) { return ((size_t)(chunk * 4 + h) * 2 + dir) * 2048; }
__device__ __forceinline__ int chunk_row0(int b, int cidx) { return cidx < 4 ? NLAT + b * CTXL + 64 * cidx : b * SEQ + 64 * (cidx - 4); }
__device__ __forceinline__ int p2_cidx(int dir, int step) { return dir == 0 ? step : (step < 4 ? 3 - step : 39 - step); }
struct P1In { float g[8]; u32x4 qw, kw, v0, v1; };
__device__ __forceinline__ P1In part1_load(const Params& P, int b, int h, int cidx) {
  const int tid = tid_now(), dir = tid >> 8, t4 = tid & 255; const int row0 = chunk_row0(b, cidx);
  P1In in; const int d = t4 & 31, seg = t4 >> 5;
#pragma unroll
  for (int e = 0; e < 8; ++e) { const int ip = 8 * seg + e; const int row = row0 + (dir ? 63 - ip : ip); in.g[e] = ((float*)(P.ws + WS_GATE))[gblk(row0 >> 6, h, dir) + (size_t)(row - row0) * 32 + d]; }
  const int prow = row0 + (dir ? 63 - (t4 >> 2) : (t4 >> 2));
  const bf16_t* pr_ = ((bf16_t*)(P.ws + WS_PROJ)) + (size_t)prow * NPROJ;
  in.qw = *(const u32x4*)(pr_ + C_DQ + h * 32 + 8 * (t4 & 3)); in.kw = *(const u32x4*)(pr_ + C_DK + h * 32 + 8 * (t4 & 3));
  in.v0 = *(const u32x4*)(pr_ + C_DV + h * 64 + 16 * (t4 & 3)); in.v1 = *(const u32x4*)(pr_ + C_DV + h * 64 + 16 * (t4 & 3) + 8);
  return in;
}
__device__ __forceinline__ void unit(const Params& P, int layer, int b, int h, unsigned char* lds) {
  const int tid = tid_now(), dir = tid >> 8, t4 = tid & 255, w4 = (tid >> 6) & 3, lane = tid & 63, r32 = lane & 31, hi = lane >> 5;
  unsigned char* base = lds + dir * GRP_BYTES;
  float* Gs = (float*)base;
  float* SEG = Gs + 64 * 33;
  float* GL = SEG + 256;
  bf16_t* QEs = (bf16_t*)(base + 9600);
  bf16_t* KDs = QEs + 64 * 40;
  bf16_t* KEt = KDs + 64 * 40;
  bf16_t* Vt = KEt + 32 * 72;
  bf16_t* As = Vt + 64 * 72;
  bf16_t* St = (bf16_t*)(base + 43008);
  bf16_t* Os = (bf16_t*)(base + 53248);
  f32x16 Sreg = {0.f, 0.f, 0.f, 0.f, 0.f, 0.f, 0.f, 0.f, 0.f, 0.f, 0.f, 0.f, 0.f, 0.f, 0.f, 0.f};
  __syncthreads();
#pragma unroll
  for (int i = 0; i < 5; ++i) ((unsigned*)St)[t4 + 256 * i] = 0u;
  P1In cur = part1_load(P, b, h, p2_cidx(dir, 0));
  for (int s = 0; s < 36; ++s) {
    const int cidx = p2_cidx(dir, s); const int row0 = chunk_row0(b, cidx);
    const P1In in = cur; cur = part1_load(P, b, h, p2_cidx(dir, s < 35 ? s + 1 : 35));
    const u32x4 qw = in.qw, kw = in.kw, v0 = in.v0, v1 = in.v1;
    __syncthreads();
    if (s > 0) { const int tok = t4 >> 2, sg = t4 & 3; const int rowp = chunk_row0(b, p2_cidx(dir, s - 1)) + tok;
      bf16_t* op = of_row(P, dir, rowp) + h * 64 + sg * 16;
      const u32x4 o0 = *(const u32x4*)(Os + tok * 72 + sg * 16), o1 = *(const u32x4*)(Os + tok * 72 + sg * 16 + 8); *(u32x4*)op = o0; *(u32x4*)(op + 8) = o1; }
    { const int d = t4 & 31, seg = t4 >> 5;
      float p[8]; float run = 0.f;
#pragma unroll
      for (int e = 0; e < 8; ++e) { run += in.g[e]; p[e] = run; }
      SEG[seg * 32 + d] = run;
      __syncthreads();
      float off = 0.f;
#pragma unroll
      for (int s2 = 0; s2 < 8; ++s2) { const float sv = SEG[s2 * 32 + d]; off += (s2 < seg) ? sv : 0.f; }
#pragma unroll
      for (int e = 0; e < 8; ++e) Gs[(8 * seg + e) * 33 + d] = p[e] + off;
      if (seg == 7) GL[d] = p[7] + off;
    }
    __syncthreads();
    { const int ip = t4 >> 2, o8 = t4 & 3;
      const float q[8] = {bflo(qw.x), bfhi(qw.x), bflo(qw.y), bfhi(qw.y), bflo(qw.z), bfhi(qw.z), bflo(qw.w), bfhi(qw.w)};
      const float k[8] = {bflo(kw.x), bfhi(kw.x), bflo(kw.y), bfhi(kw.y), bflo(kw.z), bfhi(kw.z), bflo(kw.w), bfhi(kw.w)};
      float qe[8], kd[8], ke[8];
#pragma unroll
      for (int e = 0; e < 8; ++e) { const float G = Gs[ip * 33 + 8 * o8 + e], gl = GL[8 * o8 + e]; qe[e] = q[e] * __expf(G); kd[e] = k[e] * __expf(-G); ke[e] = k[e] * __expf(gl - G); }
      *(u32x4*)(QEs + ip * 40 + 8 * o8) = (u32x4){pk2(qe[0], qe[1]), pk2(qe[2], qe[3]), pk2(qe[4], qe[5]), pk2(qe[6], qe[7])};
      *(u32x4*)(KDs + ip * 40 + 8 * o8) = (u32x4){pk2(kd[0], kd[1]), pk2(kd[2], kd[3]), pk2(kd[4], kd[5]), pk2(kd[6], kd[7])};
#pragma unroll
      for (int e = 0; e < 8; ++e) KEt[(8 * o8 + e) * 72 + ip] = (bf16_t)f2bf(ke[e]);
      const unsigned vw[8] = {v0.x, v0.y, v0.z, v0.w, v1.x, v1.y, v1.z, v1.w};
#pragma unroll
      for (int e = 0; e < 8; ++e) { Vt[(16 * o8 + 2 * e) * 72 + ip] = (bf16_t)(vw[e] & 0xffffu); Vt[(16 * o8 + 2 * e + 1) * 72 + ip] = (bf16_t)(vw[e] >> 16); }
    }
    __syncthreads();
    { const int it = w4 >> 1, jt = w4 & 1;
      f32x16 acc = {0.f, 0.f, 0.f, 0.f, 0.f, 0.f, 0.f, 0.f, 0.f, 0.f, 0.f, 0.f, 0.f, 0.f, 0.f, 0.f};
      if (!(it == 0 && jt == 1)) {
#pragma unroll
        for (int s2 = 0; s2 < 2; ++s2) { const bf16x8 a = *(const bf16x8*)(QEs + (32 * it + r32) * 40 + 16 * s2 + 8 * hi); const bf16x8 bb = *(const bf16x8*)(KDs + (32 * jt + r32) * 40 + 16 * s2 + 8 * hi);
          acc = __builtin_amdgcn_mfma_f32_32x32x16_bf16(a, bb, acc, 0, 0, 0); } }
#pragma unroll
      for (int r = 0; r < 16; ++r) { const int ip = 32 * it + crow(r, hi), jp = 32 * jt + r32; As[ip * 72 + jp] = (bf16_t)f2bf(jp <= ip ? acc[r] : 0.f); }
    }
    __syncthreads();
    { const int it = w4 >> 1, nt = w4 & 1;
      const bf16_t* Sc = St + (s & 1) * 2560; bf16_t* Sn = St + ((s + 1) & 1) * 2560;
      f32x16 acc = {0.f, 0.f, 0.f, 0.f, 0.f, 0.f, 0.f, 0.f, 0.f, 0.f, 0.f, 0.f, 0.f, 0.f, 0.f, 0.f};
#pragma unroll
      for (int s2 = 0; s2 < 4; ++s2) { const bf16x8 a = *(const bf16x8*)(As + (32 * it + r32) * 72 + 16 * s2 + 8 * hi); const bf16x8 bb = *(const bf16x8*)(Vt + (32 * nt + r32) * 72 + 16 * s2 + 8 * hi);
        acc = __builtin_amdgcn_mfma_f32_32x32x16_bf16(a, bb, acc, 0, 0, 0); }
#pragma unroll
      for (int s2 = 0; s2 < 2; ++s2) { const bf16x8 a = *(const bf16x8*)(QEs + (32 * it + r32) * 40 + 16 * s2 + 8 * hi); const bf16x8 bb = *(const bf16x8*)(Sc + (32 * nt + r32) * 40 + 16 * s2 + 8 * hi);
        acc = __builtin_amdgcn_mfma_f32_32x32x16_bf16(a, bb, acc, 0, 0, 0); }
#pragma unroll
      for (int r = 0; r < 16; ++r) { const int ip = 32 * it + crow(r, hi); Os[(dir ? 63 - ip : ip) * 72 + 32 * nt + r32] = (bf16_t)f2bf(acc[r]); }
      if (w4 < 2) {
        f32x16 au = {0.f, 0.f, 0.f, 0.f, 0.f, 0.f, 0.f, 0.f, 0.f, 0.f, 0.f, 0.f, 0.f, 0.f, 0.f, 0.f};
#pragma unroll
        for (int s2 = 0; s2 < 4; ++s2) { const bf16x8 a = *(const bf16x8*)(KEt + r32 * 72 + 16 * s2 + 8 * hi); const bf16x8 bb = *(const bf16x8*)(Vt + (32 * w4 + r32) * 72 + 16 * s2 + 8 * hi);
          au = __builtin_amdgcn_mfma_f32_32x32x16_bf16(a, bb, au, 0, 0, 0); }
#pragma unroll
        for (int r = 0; r < 16; ++r) Sreg[r] = __expf(GL[crow(r, hi)]) * Sreg[r] + au[r];
#pragma unroll
        for (int q = 0; q < 4; ++q) *(u32x2*)(Sn + (32 * w4 + r32) * 40 + 8 * q + 4 * hi) = (u32x2){pk2(Sreg[4 * q], Sreg[4 * q + 1]), pk2(Sreg[4 * q + 2], Sreg[4 * q + 3])};
      }
    }
  }
  __syncthreads();
  { const int tok = t4 >> 2, sg = t4 & 3; const int rowp = chunk_row0(b, p2_cidx(dir, 35)) + tok;
    bf16_t* op = of_row(P, dir, rowp) + h * 64 + sg * 16;
    const u32x4 o0 = *(const u32x4*)(Os + tok * 72 + sg * 16), o1 = *(const u32x4*)(Os + tok * 72 + sg * 16 + 8); *(u32x4*)op = o0; *(u32x4*)(op + 8) = o1; }
  asm volatile("s_waitcnt vmcnt(0)" ::: "memory");
  __syncthreads();
  { const int wave = tid >> 6; const bool last = layer == DEPTH - 1;
    const int v4 = (lane & 15) * 4; const f32x4 g4 = *(const f32x4*)(PVEC(P) + PV_GLAG + layer * 64 + v4);
    for (int grp = 0; grp < 8; ++grp) {
      u32x2 a[9], bq[9], zw[9];
#pragma unroll
      for (int k = 0; k < 9; ++k) { const int itx = wave + 8 * (9 * grp + k); const int r = itx * 4 + (lane >> 4), cidx = r >> 6, ri = r & 63; const size_t row = (size_t)chunk_row0(b, cidx) + ri;
        a[k] = *(const u32x2*)(of_row(P, 0, (int)row) + h * 64 + v4); bq[k] = *(const u32x2*)(of_row(P, 1, (int)row) + h * 64 + v4);
        zw[k] = *(const u32x2*)(((bf16_t*)(P.ws + WS_PROJ)) + row * NPROJ + C_DZ + h * 64 + v4); }
#pragma unroll
      for (int k = 0; k < 9; ++k) { const int itx = wave + 8 * (9 * grp + k); const int r = itx * 4 + (lane >> 4), cidx = r >> 6, ri = r & 63; const size_t row = (size_t)chunk_row0(b, cidx) + ri;
        const f32x4 o = {bflo(a[k].x) + bflo(bq[k].x), bfhi(a[k].x) + bfhi(bq[k].x), bflo(a[k].y) + bflo(bq[k].y), bfhi(a[k].y) + bfhi(bq[k].y)};
        float ss = (o.x * o.x + o.y * o.y) + (o.z * o.z + o.w * o.w);
        ss += __shfl_xor(ss, 1); ss += __shfl_xor(ss, 2); ss += __shfl_xor(ss, 4); ss += __shfl_xor(ss, 8);
        const float rs = rsqrtf(ss * (1.f / 64.f) + EPS);
        if (!(last && cidx < 4)) *(u32x2*)(((bf16_t*)(P.ws + WS_Y)) + row * DM + 768 + h * 64 + v4) = (u32x2){pk2(o.x * rs * g4.x * bflo(zw[k].x), o.y * rs * g4.y * bfhi(zw[k].x)), pk2(o.z * rs * g4.z * bflo(zw[k].y), o.w * rs * g4.w * bfhi(zw[k].y))}; }
    }
  }
  __syncthreads();
}
}
struct SguIn { u32x4 w[8]; };
__device__ __forceinline__ SguIn sgu_load(const Params& P, int ch) {
  const int tid = tid_now(); const int pos = tid >> 2, q4 = tid & 3; const bf16_t* src = ((bf16_t*)(P.ws + WS_PROJ)) + (size_t)(ch * 128 + pos) * NPROJ + C_CV + q4 * 64;
  SguIn in;
#pragma unroll
  for (int c = 0; c < 8; ++c) in.w[c] = *(const u32x4*)(src + 8 * c);
  return in;
}
__device__ __forceinline__ void sgu_unit(const Params& P, int layer, int ch, const SguIn& sin, unsigned char* lds) {
  typedef short bf16x8 __attribute__((ext_vector_type(8)));
  typedef float f32x16 __attribute__((ext_vector_type(16)));
  bf16_t* vnT = (bf16_t*)lds;
  const int tid = tid_now(), wave = tid >> 6, lane = tid & 63, r32 = lane & 31, hi = lane >> 5; const int row0 = ch * 128;
  const int g = wave >> 1, ct = wave & 1;
  bf16_t* Ub = (bf16_t*)(lds + 69632 + wave * 5120); bf16_t* Zb = Ub + 1280;
  float* sgb = (float*)(lds + 110592);
  float* lgs = (float*)(lds + 112640);
  const bf16_t* W = (const bf16_t*)(P.ws + WS_SGW) + (size_t)(layer * 4 + g) * 128 * 128;
  const int cb = g * 64 + 32 * ct, lrow = lane >> 1, lhalf = lane & 1;
  const bf16_t* pj = ((bf16_t*)(P.ws + WS_PROJ)) + (size_t)(row0 + lrow) * NPROJ + cb + lhalf * 16;
  bf16_t* yo = ((bf16_t*)(P.ws + WS_Y)) + (size_t)(row0 + lrow) * DM + 512 + cb + lhalf * 16;
  const float sv = PVEC(P)[PV_SGB + layer * 512 + tid], lv = tid < 256 ? PVEC(P)[PV_LNG + layer * 256 + tid] : PVEC(P)[PV_LNB + layer * 256 + tid - 256];
  bf16x8 wA[8], wB[8]; u32x4 uz[4][4];
#define SGU_LOAD(w_, it_) do { _Pragma("unroll") for (int s = 0; s < 8; ++s) w_[s] = *(const bf16x8*)(W + (size_t)(32 * (it_) + r32) * 128 + 16 * s + 8 * hi); } while (0)
#define SGU_PUT(it_) do { *(u32x4*)(Ub + lrow * 40 + lhalf * 16) = uz[it_][0]; *(u32x4*)(Ub + lrow * 40 + lhalf * 16 + 8) = uz[it_][1]; *(u32x4*)(Zb + lrow * 40 + lhalf * 16) = uz[it_][2]; *(u32x4*)(Zb + lrow * 40 + lhalf * 16 + 8) = uz[it_][3]; } while (0)
#define SGU_TILE(w_, it_) do { f32x16 acc = {0.f, 0.f, 0.f, 0.f, 0.f, 0.f, 0.f, 0.f, 0.f, 0.f, 0.f, 0.f, 0.f, 0.f, 0.f, 0.f}; \
      _Pragma("unroll") for (int s = 0; s < 8; ++s) acc = __builtin_amdgcn_mfma_f32_32x32x16_bf16(w_[s], bfr[s], acc, 0, 0, 0); \
      float ov[16]; \
      _Pragma("unroll") for (int r = 0; r < 16; ++r) { const int il = (r & 3) + 8 * (r >> 2) + 4 * hi; ov[r] = bf2f(Ub[il * 40 + r32]) * (acc[r] + sgb[g * 128 + 32 * (it_) + il]) * bf2f(Zb[il * 40 + r32]); } \
      _Pragma("unroll") for (int r = 0; r < 16; ++r) { const int il = (r & 3) + 8 * (r >> 2) + 4 * hi; Ub[il * 40 + r32] = (bf16_t)f2bf(ov[r]); } \
      const u32x4 o0 = *(const u32x4*)(Ub + lrow * 40 + lhalf * 16), o1 = *(const u32x4*)(Ub + lrow * 40 + lhalf * 16 + 8); \
      bf16_t* y_ = yo + (size_t)(32 * (it_)) * DM; *(u32x4*)y_ = o0; *(u32x4*)(y_ + 8) = o1; } while (0)
  SGU_LOAD(wA, 0);
#pragma unroll
  for (int it = 0; it < 4; ++it) { const bf16_t* p_ = pj + (size_t)(32 * it) * NPROJ; uz[it][0] = *(const u32x4*)(p_ + C_CU); uz[it][1] = *(const u32x4*)(p_ + C_CU + 8); uz[it][2] = *(const u32x4*)(p_ + C_CZ); uz[it][3] = *(const u32x4*)(p_ + C_CZ + 8); }
  sgb[tid] = sv; lgs[tid] = lv;
  __syncthreads();
  { const int pos = tid >> 2, q4 = tid & 3;
    float x[64];
#pragma unroll
    for (int c = 0; c < 8; ++c) { const u32x4 w = sin.w[c]; x[8 * c] = bflo(w.x); x[8 * c + 1] = bfhi(w.x); x[8 * c + 2] = bflo(w.y); x[8 * c + 3] = bfhi(w.y); x[8 * c + 4] = bflo(w.z); x[8 * c + 5] = bfhi(w.z); x[8 * c + 6] = bflo(w.w); x[8 * c + 7] = bfhi(w.w); }
    float s = 0.f;
#pragma unroll
    for (int c = 0; c < 64; ++c) s += x[c];
    s += __shfl_xor(s, 1); s += __shfl_xor(s, 2);
    const float mu = s * (1.f / 256.f); float s2 = 0.f;
#pragma unroll
    for (int c = 0; c < 64; ++c) { const float d = x[c] - mu; s2 += d * d; }
    s2 += __shfl_xor(s2, 1); s2 += __shfl_xor(s2, 2);
    const float rstd = rsqrtf(s2 * (1.f / 256.f) + EPS);
    const float* lg = lgs + q4 * 64; const float* lb = lgs + 256 + q4 * 64;
#pragma unroll
    for (int c = 0; c < 64; ++c) vnT[(q4 * 64 + c) * 136 + pos] = (bf16_t)f2bf((x[c] - mu) * rstd * lg[c] + lb[c]); }
  __syncthreads();
  { bf16x8 bfr[8];
#pragma unroll
    for (int s = 0; s < 8; ++s) bfr[s] = *(const bf16x8*)(vnT + (g * 64 + 32 * ct + r32) * 136 + 16 * s + 8 * hi);
    SGU_PUT(0);
    SGU_LOAD(wB, 1); SGU_TILE(wA, 0); SGU_PUT(1);
    SGU_LOAD(wA, 2); SGU_TILE(wB, 1); SGU_PUT(2);
    SGU_LOAD(wB, 3); SGU_TILE(wA, 2); SGU_PUT(3);
    SGU_TILE(wB, 3);
#undef SGU_LOAD
#undef SGU_PUT
#undef SGU_TILE
  }
  __syncthreads();
}
constexpr int XQ_A0 = 0, XQ_B0 = 64, XQ_S0 = 128, XQ_CA0 = 164, XQ_CB0 = 172, XQ_N = 180;
__device__ __forceinline__ int xq_pull(unsigned* ctr, int x0, int& lst) {
  if (gridDim.x == 256 && lst > 0) lst = 8;
  while (lst < 8) { const int x = (x0 + lst) & 7; const unsigned u = atomicAdd(ctr + x * 64, 1u); if (u < (unsigned)XQ_N) return x * 256 + (int)u; lst = gridDim.x == 256 ? 8 : lst + 1; }
  return -1;
}
__device__ __forceinline__ int xq_attn(int code, bool last) {
  if (code < 0) return -1;
  const int x = code >> 8, u = code & 255; int g, t;
  if (u < XQ_B0) { g = 8 * x + ((u - XQ_A0) >> 3); t = 0; }
  else if (u < XQ_S0) { g = 8 * x + ((u - XQ_B0) >> 3); t = 1; }
  else if (u < XQ_CA0 || last) return -1;
  else if (u < XQ_CB0) { g = 8 * x + (u - XQ_CA0); t = 0; }
  else { g = 8 * x + (u - XQ_CB0); t = 1; }
  return (t << 12) | ((g >> 2) << 4) | (g & 3);
}
__device__ __forceinline__ void mix_phase(const Params& P, int layer, unsigned char* lds, unsigned* ctr) {
  volatile __attribute__((address_space(3))) int* shu = (volatile __attribute__((address_space(3))) int*)((__attribute__((address_space(3))) unsigned char*)lds + LDS_BYTES - 64);
  const bool last = layer == DEPTH - 1;
  for (int g = (int)blockIdx.x; g < 64; g += (int)gridDim.x) gla::unit(P, layer, 2 * (g & 7) + (g >> 5), (g >> 3) & 3, lds);
  __syncthreads();
  if (tid_now() == 0) { int lst = 0; const int x0 = (int)(blockIdx.x & 7); shu[0] = xq_pull(ctr, x0, lst); shu[1] = xq_pull(ctr, x0, lst); shu[2] = lst; shu[3] = 0; }
  __syncthreads();
  for (;;) {
    const int c0 = __builtin_amdgcn_readfirstlane(shu[0]);
    if (c0 < 0) break;
    unsigned pend = 0u;
    if (tid_now() == 0) { const int lst = shu[2]; if (lst < 8) pend = atomicAdd(ctr + (((int)(blockIdx.x & 7) + lst) & 7) * 64, 1u); }
    { const int x = c0 >> 8, u = c0 & 255; const int an = xq_attn(c0, last), nx = xq_attn(__builtin_amdgcn_readfirstlane(shu[1]), last); const bool pre = __builtin_amdgcn_readfirstlane(shu[3]) != 0;
      __syncthreads();
      if (tid_now() == 0) shu[3] = (an >= 0 && nx >= 0) ? 1 : 0;
      if (an >= 0) { const int b = (an >> 4) & 15, h = an & 3;
        if (u < XQ_S0) { const int qb = (u - XQ_A0) & 7; if ((an >> 12) == 0) att::attn_unit<0, 8>(P, layer, b, h, qb, (char*)lds, pre, nx); else att::attn_unit<1, 8>(P, layer, b, h, qb, (char*)lds, pre, nx); }
        else { if ((an >> 12) == 0) att::attn_unit<0, 8>(P, layer, b, h, 8, (char*)lds, pre, nx); else att::attn_unit<1, 8>(P, layer, b, h, 8, (char*)lds, pre, nx); } }
      else if (u >= XQ_S0 && u < XQ_CA0) { const int k = u - XQ_S0; const int ch = k < 32 ? 32 * x + k : 256 + 4 * x + (k - 32);
        if (!(last && k >= 32)) { const SguIn si = sgu_load(P, ch); sgu_unit(P, layer, ch, si, lds); } } }
    __syncthreads();
    if (tid_now() == 0) { int lst = shu[2]; const int x0 = (int)(blockIdx.x & 7); int c2 = -1;
      if (lst < 8) { if (pend < (unsigned)XQ_N) c2 = ((x0 + lst) & 7) * 256 + (int)pend; else { ++lst; c2 = xq_pull(ctr, x0, lst); } }
      shu[0] = shu[1]; shu[1] = c2; shu[2] = lst; }
    __syncthreads();
  }
}

#define LAS __attribute__((address_space(3)))
#define XB_TMO      128
#define XB_XCNT(j)  (256  + 64 * (j))
#define XB_XSUB(j)  (1280 + 64 * (j))
#define XB_XGEN(j)  (2304 + 64 * (j))
#define XB_TOP      3328
#define XB_TOPGEN   3392
#define XCD_BAR_WORDS 3456
#define XB_SPIN_CAP (1u << 18)

__device__ __forceinline__ unsigned xb_ld(unsigned* p)              { return __hip_atomic_load(p, __ATOMIC_RELAXED, __HIP_MEMORY_SCOPE_AGENT); }
__device__ __forceinline__ unsigned xb_add(unsigned* p, unsigned v) { return __hip_atomic_fetch_add(p, v, __ATOMIC_RELAXED, __HIP_MEMORY_SCOPE_AGENT); }
__device__ __forceinline__ unsigned xb_xcc_id() { return (unsigned)__builtin_amdgcn_s_getreg((3 << 11) | 20) & 0xFu; }
#define XB_SPIN(cond, bar) do { unsigned _sp = 0; while (cond) { __builtin_amdgcn_s_sleep(1); \
    if ((++_sp & 255u) == 0u) { if (xb_ld(&(bar)[XB_TMO])) break; if (_sp > XB_SPIN_CAP) { atomicAdd(&(bar)[XB_TMO], 1u); break; } } } } while (0)

struct XcdBarrier {
    unsigned* bar; unsigned x;
    volatile LAS unsigned* st;
};

__device__ __forceinline__ XcdBarrier xcd_barrier_post(unsigned* bar, volatile LAS unsigned* st) {
    XcdBarrier b; b.bar = bar; b.x = xb_xcc_id(); b.st = st;
    if (threadIdx.x == 0) (void)xb_add(&bar[XB_XCNT(b.x)], 1u);
    return b;
}
__device__ __forceinline__ void xcd_barrier_complete(unsigned* bar, unsigned x, unsigned& nloc, unsigned& nx) {
    const unsigned G = gridDim.x * gridDim.y * gridDim.z;
    unsigned sum, cnt, mine, sp = 0u;
    for (;;) {
        sum = 0u; cnt = 0u; mine = 0u;
#pragma unroll
        for (unsigned j = 0; j < 16; ++j) { const unsigned c = xb_ld(&bar[XB_XCNT(j)]); sum += c; cnt += (c > 0u) ? 1u : 0u; mine = (j == x) ? c : mine; }
        if (sum == G) break;
        __builtin_amdgcn_s_sleep(1);
        if ((++sp & 255u) == 0u) { if (xb_ld(&bar[XB_TMO])) break; if (sp > XB_SPIN_CAP) { atomicAdd(&bar[XB_TMO], 1u); break; } }
    }
    nloc = mine > 0u ? mine : 1u; nx = cnt > 0u ? cnt : 1u;
}

__device__ __forceinline__ void xcd_barrier(const XcdBarrier& b) {
    asm volatile("s_waitcnt vmcnt(0)" ::: "memory");
    __syncthreads();
    if (threadIdx.x == 0) {
        unsigned* bar = b.bar;
        __builtin_amdgcn_s_waitcnt(0);
        unsigned nloc = b.st[0], nx = b.st[1];
        if (nloc == 0u) { xcd_barrier_complete(bar, b.x, nloc, nx); b.st[0] = nloc; b.st[1] = nx; }
        const unsigned old = xb_add(&bar[XB_XSUB(b.x)], 1u);
        const unsigned gen = old / nloc;
        if (old + 1u == (gen + 1u) * nloc) {
            __builtin_amdgcn_fence(__ATOMIC_RELEASE, "agent");
            asm volatile("s_waitcnt vmcnt(0)" ::: "memory");
            const unsigned og = xb_add(&bar[XB_TOP], 1u);
            const unsigned tg = og / nx;
            if (og + 1u == (tg + 1u) * nx) xb_add(&bar[XB_TOPGEN], 1u);
            else XB_SPIN(xb_ld(&bar[XB_TOPGEN]) == tg, bar);
            __builtin_amdgcn_fence(__ATOMIC_ACQUIRE, "agent");
            xb_add(&bar[XB_XGEN(b.x)], 1u);
            asm volatile("s_waitcnt vmcnt(0)" ::: "memory");
        } else {
            XB_SPIN(xb_ld(&bar[XB_XGEN(b.x)]) == gen, bar);
            __builtin_amdgcn_fence(__ATOMIC_ACQUIRE, "agent");
            asm volatile("s_waitcnt vmcnt(0)" ::: "memory");
        }
    }
    __syncthreads();
}

__device__ __forceinline__ unsigned l2_add(unsigned* p, unsigned v) { unsigned r; asm volatile("global_atomic_add %0, %1, %2, off sc0\n\ts_waitcnt vmcnt(0)" : "=&v"(r) : "v"(p), "v"(v) : "memory"); return r; }
__device__ __forceinline__ void xgroup_barrier(unsigned* cnt, bool local) {
  asm volatile("s_waitcnt vmcnt(0)" ::: "memory");
  __syncthreads();
  if (threadIdx.x == 0) {
    unsigned sp = 0u;
    if (local) {
      const unsigned old = l2_add(cnt, 1u); const unsigned tgt = (old / 32u + 1u) * 32u;
      while (l2_add(cnt, 0u) < tgt) { __builtin_amdgcn_s_sleep(1); if (++sp > (1u << 20)) break; }
    } else {
      __builtin_amdgcn_fence(__ATOMIC_RELEASE, "agent");
      asm volatile("s_waitcnt vmcnt(0)" ::: "memory");
      const unsigned old = __hip_atomic_fetch_add(cnt, 1u, __ATOMIC_RELAXED, __HIP_MEMORY_SCOPE_AGENT); const unsigned tgt = (old / 32u + 1u) * 32u;
      while (__hip_atomic_load(cnt, __ATOMIC_RELAXED, __HIP_MEMORY_SCOPE_AGENT) < tgt) { __builtin_amdgcn_s_sleep(1); if (++sp > (1u << 22)) break; }
    }
    __builtin_amdgcn_fence(__ATOMIC_ACQUIRE, "agent");
    asm volatile("s_waitcnt vmcnt(0)" ::: "memory");
  }
  __syncthreads();
}
__global__ void __launch_bounds__(NTHREADS, 2) mega(Params P) {
  extern __shared__ __attribute__((aligned(16))) unsigned char lds[];
  cg::grid_group grid = cg::this_grid();
  float* ldsf = (float*)lds;
  volatile LAS unsigned* xst = (volatile LAS unsigned*)((LAS unsigned char*)lds + LDS_BYTES - 32);
  if (threadIdx.x < 2) xst[threadIdx.x] = 0u;
  __syncthreads();
  (void)xcd_barrier_post(((unsigned*)(P.ws + WS_CTL)) + 4096, xst);
  if (threadIdx.x == 0) __hip_atomic_store(((unsigned*)(P.ws + WS_CTL)) + 65536 + blockIdx.x, xb_xcc_id() + 1u, __ATOMIC_RELAXED, __HIP_MEMORY_SCOPE_AGENT);
#define GSYNC() do { XcdBarrier xb_; xb_.bar = ((unsigned*)(P.ws + WS_CTL)) + 4096; xb_.x = xb_xcc_id(); xb_.st = (volatile LAS unsigned*)((LAS unsigned char*)lds + LDS_BYTES - 32); xcd_barrier(xb_); } while (0)
  p0_mod(P, ldsf); p0_tables(P); p0_fold(P); p0_weights<0>(P, ldsf, 0, 1, 0);
  if (P.ws == nullptr) grid.sync();
  GSYNC();
  p0_weights<1>(P, ldsf, 0, 1, 0); __syncthreads(); p0_bias(P, ldsf, 0, DEPTH, 0); p0_xs(P);
  GSYNC();
  if (threadIdx.x == 0) { unsigned same = gridDim.x == 256 ? 1u : 0u; const unsigned mine = xb_xcc_id() + 1u;
    if (same) for (int j = 0; j < 32; ++j) same &= (__hip_atomic_load(((unsigned*)(P.ws + WS_CTL)) + 65536 + j * 8 + (blockIdx.x & 7), __ATOMIC_RELAXED, __HIP_MEMORY_SCOPE_AGENT) == mine) ? 1u : 0u;
    xst[2] = same; }
  __syncthreads();
#define XSYNC() do { if (gridDim.x == 256) xgroup_barrier(((unsigned*)(P.ws + WS_CTL)) + 8192 + 64 * (blockIdx.x & 7), ((volatile LAS unsigned*)((LAS unsigned char*)lds + LDS_BYTES - 32))[2] != 0u); else GSYNC(); } while (0)
  for (int i = tid_now(); i < 3080; i += NTHREADS) ((float*)(lds + LDS_TAB))[i] = ((float*)(P.ws + WS_TAB))[i];
  Params Pl = P;
#define OPQ() do { __attribute__((address_space(1))) unsigned char* g_ = (__attribute__((address_space(1))) unsigned char*)Pl.ws; asm volatile("" : "+s"(g_)); Pl.ws = (unsigned char*)g_; } while (0)
  for (int layer = 0; layer < DEPTH; ++layer) {
    OPQ();
    { EpiIn E{Pl, layer, (const float*)(lds + LDS_RSTD), (const float*)(lds + LDS_TAB), (const float*)(lds + LDS_BIASU), (const float*)(lds + LDS_QKN)}; pg8::Gemm g{((bf16_t*)(Pl.ws + WS_XS)), ((bf16_t*)(Pl.ws + WS_WTIN)) + (size_t)layer * NPROJ * DM, MROWS, NPROJ, DM}; pg8::XcdOrder S; int bid_ = (int)blockIdx.x; asm volatile("" : "+s"(bid_)); if (gridDim.x == 256) S.init(18, NPROJ / 256, 32, bid_ >> 3, 16 * (bid_ & 7), 128 + 2 * (bid_ & 7), 16); else S.init(MROWS / 256, NPROJ / 256, (int)gridDim.x, bid_, 0, 128, 128);
      { const int t_ = tid_now(); pg8::Unit u_;
#pragma unroll
        for (int ui = 0; ui < 8; ++ui) if (S.next(ui, u_) && t_ < 256) { const f32x4* sp = (const f32x4*)(((float*)(Pl.ws + WS_SSP)) + (size_t)(u_.pm * 256 + t_) * 16); const f32x4 s0 = sp[0], s1 = sp[1], s2 = sp[2], s3 = sp[3];
          const float ssq = ((s0.x + s0.y) + (s0.z + s0.w)) + ((s1.x + s1.y) + (s1.z + s1.w)) + ((s2.x + s2.y) + (s2.z + s2.w)) + ((s3.x + s3.y) + (s3.z + s3.w));
          ((float*)(lds + LDS_BIASU))[ui * 256 + t_] = ((float*)(Pl.ws + WS_BIAS))[(size_t)(layer * 17 + (u_.pm < 128 ? (u_.pm >> 3) : 16)) * NPROJ + u_.pn * 256 + t_];
          ((float*)(lds + LDS_RSTD))[ui * 256 + t_] = rsqrtf(ssq * (1.f / DM) + EPS); }
        if (t_ >= 256 && t_ < 384) ((float*)(lds + LDS_QKN))[t_ - 256] = PVEC(Pl)[(t_ < 320 ? PV_QN : PV_KN) + layer * 64 + (t_ & 63)];
        __syncthreads(); }
      pg8::gemm_phase<EpiIn, pg8::XcdOrder, true, true>((PG8_LAS unsigned char*)lds, g, S, E);
    }
    XSYNC(); OPQ();
    mix_phase(Pl, layer, lds, ((unsigned*)(Pl.ws + WS_CTL)) + 512 * layer);
    XSYNC(); OPQ();
    { const int Mo = layer == DEPTH - 1 ? NLAT : MROWS; pg8::Gemm g{((bf16_t*)(Pl.ws + WS_Y)), ((bf16_t*)(Pl.ws + WS_WTOUT)) + (size_t)layer * DM * DM, Mo, DM, DM}; pg8::XcdOrder S; int bid_ = (int)blockIdx.x; asm volatile("" : "+s"(bid_)); if (gridDim.x == 256) S.init(Mo / 256 / 8, DM / 256, 32, bid_ >> 3, 16 * (bid_ & 7), 128 + 2 * (bid_ & 7), 16); else S.init(Mo / 256, DM / 256, (int)gridDim.x, bid_, 0, 128, 128);
      if (layer == 0) { EpiOut<true, false> E{Pl, layer}; pg8::gemm_phase<EpiOut<true, false>, pg8::XcdOrder, true, true>((PG8_LAS unsigned char*)lds, g, S, E); }
      else if (layer < DEPTH - 1) { EpiOut<false, false> E{Pl, layer}; pg8::gemm_phase<EpiOut<false, false>, pg8::XcdOrder, true, true>((PG8_LAS unsigned char*)lds, g, S, E); }
      else { EpiOut<false, true> E{Pl, layer}; pg8::gemm_phase<EpiOut<false, true>, pg8::XcdOrder, true, true>((PG8_LAS unsigned char*)lds, g, S, E); }
      if (layer < DEPTH - 1) { const int b0 = gridDim.x == 256 ? 64 : 0; __syncthreads(); p0_weights<2>(Pl, (float*)lds, layer + 1, layer + 2, b0);
        if (gridDim.x == 256 && (int)blockIdx.x >= b0) { asm volatile("s_waitcnt vmcnt(0)" ::: "memory"); __syncthreads();
          if (threadIdx.x == 0) { __builtin_amdgcn_fence(__ATOMIC_RELEASE, "agent"); asm volatile("s_waitcnt vmcnt(0)" ::: "memory"); (void)xb_add(((unsigned*)(Pl.ws + WS_CTL)) + 12288 + 64 * (layer + 1), 1u); } } } }
    if (layer < DEPTH - 1) XSYNC(); else GSYNC();
    OPQ();
    if (gridDim.x == 256 && layer < DEPTH - 1) {
      if (threadIdx.x == 0) { unsigned sp = 0u; while (xb_ld(((unsigned*)(Pl.ws + WS_CTL)) + 12288 + 64 * (layer + 1)) < 192u) { __builtin_amdgcn_s_sleep(1); if (++sp > (1u << 22)) break; }
        __builtin_amdgcn_fence(__ATOMIC_ACQUIRE, "agent"); asm volatile("s_waitcnt vmcnt(0)" ::: "memory"); }
      __syncthreads(); }
  }
  final_norm(P);
}

extern "C" void kernel_launch(void* const* d_in, const int* in_sizes, int n_in, void* d_out, int out_size, void* d_ws, size_t ws_size, hipStream_t stream) {
  static int grid_blocks = 0;
  if (!grid_blocks) {
    int dev = 0, cus = 0, per_cu = 0;
    (void)hipGetDevice(&dev);
    (void)hipDeviceGetAttribute(&cus, hipDeviceAttributeMultiprocessorCount, dev);
    (void)hipFuncSetAttribute((const void*)mega, hipFuncAttributeMaxDynamicSharedMemorySize, LDS_BYTES);
    (void)hipOccupancyMaxActiveBlocksPerMultiprocessor(&per_cu, (const void*)mega, NTHREADS, LDS_BYTES);
    if (per_cu < 1) per_cu = 1;
    grid_blocks = cus * per_cu;
    if (ws_size < WS_END || n_in != 26) { fprintf(stderr, "kernel_launch: bad ws_size %zu / n_in %d\n", ws_size, n_in); grid_blocks = -1; }
  }
  if (grid_blocks < 0) return;
  (void)hipMemsetAsync((char*)d_ws + WS_CTL, 0, 1 * MiB, stream);
  Params p{};
  const float** pin = (const float**)&p;
  for (int i = 0; i < 26; ++i) pin[i] = (const float*)d_in[i];
  unsigned char* ws = (unsigned char*)d_ws;
  p.out = (float*)d_out;
  p.ws = ws;
  void* args[] = {&p};
  hipError_t e = hipLaunchCooperativeKernel((void*)mega, dim3(grid_blocks), dim3(NTHREADS), args, LDS_BYTES, stream);
  if (e != hipSuccess) fprintf(stderr, "cooperative launch failed: %s (grid %d)\n", hipGetErrorString(e), grid_blocks);
}
```
